# Optimizing an MI355X kernel written in HIP

```python
import jax, jax.numpy as jnp
from jax import lax
import numpy as np

D_MODEL = 1024
BATCH = 1
SEQ = 16384
DEPTH = 1

N_META = 16
CHUNK = 64
EPS = 1e-6
M_HEADS = 4
M_DV = D_MODEL // M_HEADS
M_DQK = M_DV // 2
M_QK = M_HEADS * M_DQK
M_V = M_HEADS * M_DV
CONV_W = 4
F_BIAS = 3.0
G_HEADS = 4
G_DV = D_MODEL // G_HEADS
G_DK = G_DV // 2
G_QK = G_HEADS * G_DK
G_V = G_HEADS * G_DV
G_RANK = 16
G_TAU = 16.0
D_FF = ((8 * D_MODEL + 3 * 256 - 1) // (3 * 256)) * 256
PROJ_WIDTHS = (M_QK, M_QK, M_V, M_HEADS, M_HEADS, M_V, G_QK, G_QK, G_V, G_RANK, G_V, D_MODEL, D_MODEL)
N_PROJ = sum(PROJ_WIDTHS)

kernel_name = 'hybrid_mlstm_gla_block'


def rmsnorm(x, g):
    xf = x.astype(jnp.float32)
    y = xf * lax.rsqrt(jnp.mean(xf * xf, axis=-1, keepdims=True) + EPS)
    return (y * g.astype(jnp.float32)).astype(x.dtype)


def head_rmsnorm(h, g):
    y = h * lax.rsqrt(jnp.mean(h * h, axis=-1, keepdims=True) + EPS)
    return y * g.astype(jnp.float32)


def split_cols(p):
    idx = np.cumsum(np.array(PROJ_WIDTHS))[:-1]
    return jnp.split(p, idx, axis=-1)


def to_chunks(t, n_heads):
    b, tp = t.shape[:2]
    t = t.reshape(b, tp // CHUNK, CHUNK, n_heads, -1)
    return jnp.transpose(t, (0, 3, 1, 2, 4)).astype(jnp.float32)


def from_chunks(t):
    b, h, nc, l, d = t.shape
    return jnp.transpose(t, (0, 2, 3, 1, 4)).reshape(b, nc * l, h, d)


def causal_depthwise_conv(x, w, bias):
    k = w.shape[0]
    y = lax.conv_general_dilated(x, w[:, None, :].astype(x.dtype), window_strides=(1,),
                                 padding=[(k - 1, 0)], dimension_numbers=('NWC', 'WIO', 'NWC'),
                                 feature_group_count=x.shape[-1])
    return y + bias.astype(x.dtype)


def mlstm_chunkwise(q, k, v, logi, logf):
    L = q.shape[3]
    b = jnp.cumsum(logf, axis=-1)
    g = b[..., -1]
    causal = jnp.tril(jnp.ones((L, L), dtype=bool))
    dmat = jnp.where(causal, b[..., :, None] - b[..., None, :] + logi[..., None, :], -jnp.inf)
    wlog = g[..., None] - b + logi

    def step(carry, inp):
        C, n, m = carry
        kc, vc, wc, gc = inp
        m_new = jnp.maximum(gc + m, jnp.max(wc, axis=-1))
        a = jnp.exp(gc + m - m_new)
        w = jnp.exp(wc - m_new[..., None])
        C_new = a[..., None, None] * C + jnp.einsum('bhl,bhlv,bhlk->bhvk', w, vc, kc)
        n_new = a[..., None] * n + jnp.einsum('bhl,bhlk->bhk', w, kc)
        return (C_new, n_new, m_new), (C, n, m)

    bsz, nh, _, _, dqk = q.shape
    dv = v.shape[-1]
    init = (jnp.zeros((bsz, nh, dv, dqk), jnp.float32), jnp.zeros((bsz, nh, dqk), jnp.float32),
            jnp.zeros((bsz, nh), jnp.float32))
    xs = (jnp.moveaxis(k, 2, 0), jnp.moveaxis(v, 2, 0), jnp.moveaxis(wlog, 2, 0), jnp.moveaxis(g, 2, 0))
    _, (Cs, ns, ms) = lax.scan(step, init, xs)
    Cs = jnp.moveaxis(Cs, 0, 2)
    ns = jnp.moveaxis(ns, 0, 2)
    ms = jnp.moveaxis(ms, 0, 2)

    inter_log = b + ms[..., None]
    m_row = jnp.maximum(inter_log, jnp.max(dmat, axis=-1))
    sim = jnp.einsum('bhcjd,bhcsd->bhcjs', q, k)
    wts = jnp.exp(dmat - m_row[..., None]) * sim
    a_inter = jnp.exp(inter_log - m_row)
    num = (a_inter[..., None] * jnp.einsum('bhcvd,bhcjd->bhcjv', Cs, q)
           + jnp.einsum('bhcjs,bhcsv->bhcjv', wts, v))
    den = a_inter * jnp.einsum('bhcd,bhcjd->bhcj', ns, q) + jnp.sum(wts, axis=-1)
    return num / jnp.maximum(jnp.abs(den), jnp.exp(-m_row))[..., None]


def gla_chunked(q, k, v, loga):
    L = q.shape[3]
    bc = jnp.cumsum(loga, axis=3)
    btot = bc[..., -1, :]
    q_dec = q * jnp.exp(bc)
    k_inv = k * jnp.exp(-bc)
    k_end = k * jnp.exp(btot[..., None, :] - bc)
    causal = jnp.tril(jnp.ones((L, L), dtype=bool))
    att = jnp.where(causal, jnp.einsum('bhcjd,bhcsd->bhcjs', q_dec, k_inv), 0.0)
    intra = jnp.einsum('bhcjs,bhcsv->bhcjv', att, v)

    def step(S, inp):
        ke, vc, bt = inp
        S_new = jnp.exp(bt)[..., None] * S + jnp.einsum('bhlk,bhlv->bhkv', ke, vc)
        return S_new, S

    bsz, nh, _, _, dk = q.shape
    dv = v.shape[-1]
    S0 = jnp.zeros((bsz, nh, dk, dv), jnp.float32)
    _, S_prev = lax.scan(step, S0, (jnp.moveaxis(k_end, 2, 0), jnp.moveaxis(v, 2, 0), jnp.moveaxis(btot, 2, 0)))
    S_prev = jnp.moveaxis(S_prev, 0, 2)
    return intra + jnp.einsum('bhcjk,bhckv->bhcjv', q_dec, S_prev)


def setup_inputs(seed: int = 0) -> dict:
    key = jax.random.key(seed)
    ks = jax.random.split(key, 24)
    f32 = jnp.float32
    nrm = lambda k, shape, s: jax.random.normal(k, shape, f32) * s
    m_gate_b = jnp.stack([nrm(ks[6], (DEPTH, M_HEADS), 0.01),
                          F_BIAS + nrm(ks[7], (DEPTH, M_HEADS), 0.1)], axis=1)
    return {
        'x': nrm(ks[0], (BATCH, SEQ, D_MODEL), 1.0),
        'meta_tokens': nrm(ks[1], (N_META, D_MODEL), 1.0),
        'norm1_g': 1.0 + nrm(ks[2], (DEPTH, D_MODEL), 0.02),
        'w_in': nrm(ks[3], (DEPTH, D_MODEL, N_PROJ), D_MODEL ** -0.5),
        'conv_w': nrm(ks[4], (DEPTH, CONV_W, 2 * M_QK), CONV_W ** -0.5),
        'conv_b': nrm(ks[5], (DEPTH, 2 * M_QK), 0.01),
        'm_gate_b': m_gate_b,
        'g_a2': nrm(ks[8], (DEPTH, G_RANK, G_QK), G_RANK ** -0.5),
        'g_a2_b': nrm(ks[9], (DEPTH, G_QK), 0.01),
        'm_head_g': 1.0 + nrm(ks[10], (DEPTH, M_HEADS, M_DV), 0.02),
        'g_head_g': 1.0 + nrm(ks[11], (DEPTH, G_HEADS, G_DV), 0.02),
        'w_branch_m': nrm(ks[12], (DEPTH, M_V, D_MODEL), M_V ** -0.5),
        'w_branch_g': nrm(ks[13], (DEPTH, G_V, D_MODEL), G_V ** -0.5),
        'w_out': nrm(ks[14], (DEPTH, D_MODEL, D_MODEL), D_MODEL ** -0.5),
        'norm2_g': 1.0 + nrm(ks[15], (DEPTH, D_MODEL), 0.02),
        'w_ff_gate': nrm(ks[16], (DEPTH, D_MODEL, D_FF), D_MODEL ** -0.5),
        'w_ff_up': nrm(ks[17], (DEPTH, D_MODEL, D_FF), D_MODEL ** -0.5),
        'w_ff_down': nrm(ks[18], (DEPTH, D_FF, D_MODEL), D_FF ** -0.5),
        'final_g': 1.0 + nrm(ks[19], (D_MODEL,), 0.02),
    }


def reference(x, meta_tokens, norm1_g, w_in, conv_w, conv_b, m_gate_b, g_a2, g_a2_b, m_head_g, g_head_g,
              w_branch_m, w_branch_g, w_out, norm2_g, w_ff_gate, w_ff_up, w_ff_down, final_g):
    f32 = jnp.float32
    bsz, _, d = x.shape
    dt = x.dtype
    n_pad = CHUNK - N_META
    meta = jnp.broadcast_to(meta_tokens.astype(dt)[None], (bsz, N_META, d))
    h = jnp.concatenate([jnp.zeros((bsz, n_pad, d), dt), meta, x], axis=1)
    tp = h.shape[1]
    valid = (jnp.arange(tp) >= n_pad)[None, :, None]

    for l in range(DEPTH):
        xn = rmsnorm(h, norm1_g[l])
        proj = jnp.where(valid, xn @ w_in[l].astype(dt), 0.0).astype(dt)
        (mq, mk, mv, mi, mf, mo, gq, gk, gv, ga, gr, gate_m, gate_g) = split_cols(proj)

        mqk = jax.nn.silu(causal_depthwise_conv(jnp.concatenate([mq, mk], axis=-1), conv_w[l], conv_b[l]))
        mq, mk = jnp.split(mqk, 2, axis=-1)
        logi = jnp.where(valid, mi.astype(f32) + m_gate_b[l, 0], -jnp.inf)
        logf = jnp.where(valid, jax.nn.log_sigmoid(mf.astype(f32) + m_gate_b[l, 1]), 0.0)
        hm = mlstm_chunkwise(to_chunks(mq, M_HEADS) * (M_DQK ** -0.5), to_chunks(mk, M_HEADS),
                             to_chunks(mv, M_HEADS), to_chunks(logi, M_HEADS)[..., 0],
                             to_chunks(logf, M_HEADS)[..., 0])
        hm = head_rmsnorm(from_chunks(hm), m_head_g[l]) * jax.nn.sigmoid(mo.astype(f32)).reshape(bsz, tp, M_HEADS, M_DV)
        y_m = hm.reshape(bsz, tp, M_V).astype(dt)

        za = ga @ g_a2[l].astype(dt) + g_a2_b[l].astype(dt)
        loga = jnp.where(valid, jax.nn.log_sigmoid(za.astype(f32)) / G_TAU, 0.0)
        hg = gla_chunked(to_chunks(gq, G_HEADS) * (G_DK ** -0.5), to_chunks(gk, G_HEADS),
                         to_chunks(gv, G_HEADS), to_chunks(loga, G_HEADS))
        hg = head_rmsnorm(from_chunks(hg), g_head_g[l]) * jax.nn.silu(gr.astype(f32)).reshape(bsz, tp, G_HEADS, G_DV)
        y_g = hg.reshape(bsz, tp, G_V).astype(dt)

        merged = (jax.nn.sigmoid(gate_m) * (y_m @ w_branch_m[l].astype(dt))
                  + jax.nn.sigmoid(gate_g) * (y_g @ w_branch_g[l].astype(dt)))
        h = h + merged @ w_out[l].astype(dt)

        hn = rmsnorm(h, norm2_g[l])
        ff = jax.nn.silu(hn @ w_ff_gate[l].astype(dt)) * (hn @ w_ff_up[l].astype(dt))
        h = h + ff @ w_ff_down[l].astype(dt)

    out = rmsnorm(h, final_g)
    return out[:, CHUNK:, :]
```

```cpp
#include <hip/hip_runtime.h>
#include <hip/hip_cooperative_groups.h>
#include <cstdio>
#include <cstdint>
namespace cg = cooperative_groups;

#define LAS __attribute__((address_space(3)))
typedef unsigned short bf16_t;
typedef short bf16x8 __attribute__((ext_vector_type(8)));
typedef float f32x4 __attribute__((ext_vector_type(4)));
typedef unsigned u32x4 __attribute__((ext_vector_type(4)));
typedef unsigned u32x2 __attribute__((ext_vector_type(2)));

#ifndef N_LAUNCH_MODE
#define N_LAUNCH_MODE 1
#endif

constexpr int DM = 1024, SEQ = 16384, TP = SEQ + 64, NCH = 257, NPROJ = 8216, DFF = 2816;
constexpr float EPS = 1e-6f;
constexpr float QSCALE = 0.08838834764831845f;
constexpr int NSEG_M = 9, NSEG_G = 7;
__host__ __device__ constexpr int seg_start_b(bool ml, int g) { return ml ? (g * 257 + 4) / 9 : (g * 257 + 3) / 7; }

constexpr size_t MiB = 1u << 20;
constexpr size_t WS_SS1 = 0, WS_SS2 = 65536, WS_BAR = 131072, WS_PCNT = 147456, CTL_ZERO_BYTES = 163840;
constexpr size_t WS_GI = 1 * MiB, WS_GF = 1 * MiB + 512 * 1024, WS_GA = 2 * MiB;
constexpr size_t WS_HSS = 4 * MiB;
constexpr size_t WS_CHB = 8 * MiB, WS_CHM = 8 * MiB + 512 * 1024, WS_CHG = 9 * MiB, WS_BT = 9 * MiB + 65536, WS_SEGBT = 9 * MiB + 768 * 1024;
constexpr size_t WS_WTA = 10 * MiB, WS_WTB = 18 * MiB, WS_WTBM = 26 * MiB, WS_WTO = 30 * MiB, WS_WTFF = 32 * MiB, WS_WTD = 43 * MiB;
constexpr size_t WS_R1 = 49 * MiB;
constexpr size_t WS_R2 = 114 * MiB;
constexpr size_t WS_AQ = 179 * MiB;
constexpr size_t WS_KU = 212 * MiB;
constexpr size_t WS_SEG = 245 * MiB;
constexpr size_t WS_FF = WS_R1;
constexpr size_t WS_END = 256 * MiB;
constexpr size_t OUT_XN = 0, OUT_WW = 32 * MiB;

constexpr int LDS_BYTES = 147456, MISC_OFF = 146432;

typedef float f32x2_t __attribute__((ext_vector_type(2)));
typedef __bf16 bf16x2_t __attribute__((ext_vector_type(2)));
__device__ __forceinline__ unsigned cvt_pk_bf16(float lo, float hi) { const f32x2_t v = {lo, hi}; const bf16x2_t b = __builtin_convertvector(v, bf16x2_t); return __builtin_bit_cast(unsigned, b); }
__device__ __forceinline__ float bf_lo(unsigned u) { return __uint_as_float(u << 16); }
__device__ __forceinline__ float bf_hi(unsigned u) { return __uint_as_float(u & 0xffff0000u); }
__device__ __forceinline__ float bf2f(bf16_t b) { return __uint_as_float(((unsigned)b) << 16); }
__device__ __forceinline__ bf16_t f2bf(float f) { return (bf16_t)(cvt_pk_bf16(f, 0.f) & 0xffffu); }
#define DPP_F(old, src, ctrl, rmask, bc) __int_as_float(__builtin_amdgcn_update_dpp(__float_as_int(old), __float_as_int(src), (ctrl), (rmask), 0xf, (bc)))
__device__ __forceinline__ float wave_sum(float v) {
    v += DPP_F(0.f, v, 0xB1, 0xf, true);
    v += DPP_F(0.f, v, 0x4E, 0xf, true);
    v += DPP_F(0.f, v, 0x141, 0xf, true);
    v += DPP_F(0.f, v, 0x140, 0xf, true);
    v += DPP_F(0.f, v, 0x142, 0xa, false);
    v += DPP_F(0.f, v, 0x143, 0xc, false);
    return __int_as_float(__builtin_amdgcn_readlane(__float_as_int(v), 63));
}
__device__ __forceinline__ float wave_max(float v) {
    v = fmaxf(v, DPP_F(v, v, 0xB1, 0xf, false));
    v = fmaxf(v, DPP_F(v, v, 0x4E, 0xf, false));
    v = fmaxf(v, DPP_F(v, v, 0x141, 0xf, false));
    v = fmaxf(v, DPP_F(v, v, 0x140, 0xf, false));
    v = fmaxf(v, DPP_F(v, v, 0x142, 0xa, false));
    v = fmaxf(v, DPP_F(v, v, 0x143, 0xc, false));
    return __int_as_float(__builtin_amdgcn_readlane(__float_as_int(v), 63));
}
__device__ __forceinline__ float wave_scan_sum(float v) {
    v += DPP_F(0.f, v, 0x111, 0xf, true); v += DPP_F(0.f, v, 0x112, 0xf, true); v += DPP_F(0.f, v, 0x114, 0xf, true); v += DPP_F(0.f, v, 0x118, 0xf, true);
    v += DPP_F(0.f, v, 0x142, 0xa, false); v += DPP_F(0.f, v, 0x143, 0xc, false);
    return v;
}
__device__ __forceinline__ float wave_scan_max(float v) {
    v = fmaxf(v, DPP_F(v, v, 0x111, 0xf, false)); v = fmaxf(v, DPP_F(v, v, 0x112, 0xf, false)); v = fmaxf(v, DPP_F(v, v, 0x114, 0xf, false)); v = fmaxf(v, DPP_F(v, v, 0x118, 0xf, false));
    v = fmaxf(v, DPP_F(v, v, 0x142, 0xa, false)); v = fmaxf(v, DPP_F(v, v, 0x143, 0xc, false));
    return v;
}
__device__ __forceinline__ float sigmoidf_(float x) { return __builtin_amdgcn_rcpf(1.f + __expf(-x)); }
__device__ __forceinline__ float siluf_(float x) { return x * __builtin_amdgcn_rcpf(1.f + __expf(-x)); }
__device__ __forceinline__ float logsigmoidf_(float z) { return fminf(z, 0.f) - __logf(1.f + __expf(-fabsf(z))); }
#define LDS_BARRIER() do { asm volatile("s_waitcnt lgkmcnt(0)" ::: "memory"); __builtin_amdgcn_s_barrier(); asm volatile("" ::: "memory"); } while (0)
#define MFMA16(a, b, c) __builtin_amdgcn_mfma_f32_16x16x32_bf16((a), (b), (c), 0, 0, 0)

namespace pg8 {
constexpr int BM = 256, BK = 64, HALF = 128, HTB = HALF * BK * 2, NXCD = 8, WGM = 1;
__host__ __device__ __forceinline__ int lds_byte(int r, int c) { const int st = (r >> 4) * 2 + (c >> 5), rr = r & 15, cc = c & 31, ob = rr * 64 + cc * 2; return st * 1024 + (ob ^ (((ob >> 9) & 1) << 5)); }
__host__ __device__ __forceinline__ void stage_rc(int b, int& R, int& C) { const int st = b / 1024, sb = b % 1024, swz = sb ^ (((sb >> 9) & 1) << 5); R = (st >> 1) * 16 + swz / 64; C = (st & 1) * 32 + (swz % 64) / 2; }
__host__ __device__ __forceinline__ int perm32(int rho) { const int n = rho >> 4, i = rho & 15; return 8 * (i >> 2) + 4 * n + (i & 3); }

struct Unit { int pm, pn, ks; };
struct Gemm { const bf16_t* A; const bf16_t* Bt; int M, N, K, lda; size_t ksA, ksB; };

struct StaticOrder {
    int nM, nN, nwg, G, c;
    __device__ void init(int M, int N, int G_, int c_) { nM = M / BM; nN = N / BM; nwg = nM * nN; G = G_; c = c_; }
    __device__ bool next(int i, Unit& u) const {
        const long Lx = (long)i * G + c; if (Lx >= nwg) return false;
        int wgid = (int)Lx; { const int q = nwg / NXCD, r = nwg % NXCD, xcd = wgid % NXCD, off = wgid / NXCD; wgid = (xcd < r ? xcd * (q + 1) : r * (q + 1) + (xcd - r) * q) + off; }
        const int nig = WGM * nN, gid = wgid / nig, fm = gid * WGM, gsz = (nM - fm) < WGM ? (nM - fm) : WGM;
        u.pm = fm + ((wgid % nig) % gsz); u.pn = (wgid % nig) / gsz; u.ks = 0; return true;
    }
};
struct TwoPassOrder {
    int ntile, nN, G, c;
    __device__ void init(int M, int N, int G_, int c_) { nN = N / BM; ntile = (M / BM) * nN; G = G_; c = c_; }
    __device__ bool next(int i, Unit& u) const {
        const int cc = (G % 8 == 0) ? (c % 8) * (G / 8) + c / 8 : c;
        const int tl = (i >> 1) * G + cc; if (tl >= ntile) return false;
        u.pm = tl / nN; u.pn = tl % nN; u.ks = i & 1; return true;
    }
};

template <class Epi, class Sched>
__device__ __forceinline__ void gemm_phase(LAS unsigned char* lds, const Gemm g, const Sched& S, const Epi& E) {
    const int tid = threadIdx.x, wid = __builtin_amdgcn_readfirstlane(tid >> 6), lane = tid & 63, wr = wid >> 2, wc = wid & 3, fr = lane & 15, fq = lane >> 4;
    const int K = g.K, nt = K / BK;
    unsigned voffA[2], voffB[2];
#pragma unroll
    for (int i = 0; i < 2; ++i) { int R, C; stage_rc(tid * 16 + i * 8192, R, C); const int Rb = (R & ~31) + perm32(R & 31);
        voffA[i] = (unsigned)(R * g.lda + C) * 2u; voffB[i] = (unsigned)(Rb * K + C) * 2u; }
    const size_t kstep = (size_t)(BK * 2);
    const size_t hstepA = (size_t)HALF * g.lda * 2, hstepB = (size_t)HALF * K * 2;
    const size_t tstepA = 2 * hstepA, tstepB = 2 * hstepB;
    const unsigned ldsw = (unsigned)wid * 1024u;
    const int aoff = lds_byte(wr * 64 + fr, fq * 8), boff = lds_byte(wc * 32 + fr, fq * 8);
#define PG8_SA(b, h) (((b) * 2 + (h)) * HTB)
#define PG8_SB(b, h) ((4 + (b) * 2 + (h)) * HTB)
#define PG8_STAGE(bufoff, gbase, voff) do { _Pragma("unroll") for (int _i = 0; _i < 2; ++_i) \
        __builtin_amdgcn_global_load_lds((const unsigned*)((const char*)(gbase) + (voff)[_i]), (LAS unsigned*)(lds + (bufoff) + ldsw + _i * 8192), 16, 0, 0); } while (0)
#define PG8_LDA(dst, b, h) do { _Pragma("unroll") for (int m = 0; m < 4; ++m) _Pragma("unroll") for (int k = 0; k < 2; ++k) dst[m][k] = *(const LAS bf16x8*)(lds + PG8_SA(b, h) + aoff + m * 2048 + k * 1024); } while (0)
#define PG8_LDB(dst, b, h) do { _Pragma("unroll") for (int n = 0; n < 2; ++n) _Pragma("unroll") for (int k = 0; k < 2; ++k) dst[n][k] = *(const LAS bf16x8*)(lds + PG8_SB(b, h) + boff + n * 2048 + k * 1024); } while (0)
#define PG8_MMA(ai, bj, At, Bt) do { __builtin_amdgcn_s_setprio(1); _Pragma("unroll") for (int m = 0; m < 4; ++m) _Pragma("unroll") for (int n = 0; n < 2; ++n) _Pragma("unroll") for (int k = 0; k < 2; ++k) \
        acc[ai][bj][m][n] = __builtin_amdgcn_mfma_f32_16x16x32_bf16(Bt[n][k], At[m][k], acc[ai][bj][m][n], 0, 0, 0); __builtin_amdgcn_s_setprio(0); } while (0)
#define PG8_WAIT_V(n) asm volatile("s_waitcnt vmcnt(" #n ")" ::: "memory")
#define PG8_WAIT_L(n) asm volatile("s_waitcnt lgkmcnt(" #n ")" ::: "memory")
#define PG8_BAR __builtin_amdgcn_s_barrier()
#define PG8_SCHED __builtin_amdgcn_sched_barrier(0)
    Unit cur, nxt; int ui = 0;
    if (!S.next(0, cur)) return;
    f32x4 acc[2][2][4][2];
#pragma unroll
    for (int a = 0; a < 2; ++a)
#pragma unroll
        for (int b = 0; b < 2; ++b)
#pragma unroll
            for (int m = 0; m < 4; ++m)
#pragma unroll
                for (int n = 0; n < 2; ++n) acc[a][b][m][n] = (f32x4){0.f, 0.f, 0.f, 0.f};
    bf16x8 At[4][2], B0[2][2], B1[2][2];
    const char* cA = (const char*)g.A + (size_t)cur.pm * tstepA + (size_t)cur.ks * g.ksA; const char* cB = (const char*)g.Bt + (size_t)cur.pn * tstepB + (size_t)cur.ks * g.ksB;
    PG8_STAGE(PG8_SB(0, 0), cB, voffB); PG8_STAGE(PG8_SB(0, 1), cB + hstepB, voffB); PG8_STAGE(PG8_SA(0, 0), cA, voffA); PG8_STAGE(PG8_SA(0, 1), cA + hstepA, voffA);
    if (wr == 1) PG8_BAR;
    PG8_WAIT_V(2); PG8_BAR;
    PG8_STAGE(PG8_SB(1, 0), cB + kstep, voffB); PG8_STAGE(PG8_SA(1, 0), cA + kstep, voffA); PG8_STAGE(PG8_SB(1, 1), cB + hstepB + kstep, voffB);
    PG8_WAIT_V(6); PG8_BAR;
    for (;;) {
        const bool has_next = S.next(ui + 1, nxt);
        const char* nA = has_next ? (const char*)g.A + (size_t)nxt.pm * tstepA + (size_t)nxt.ks * g.ksA : cA; const char* nB = has_next ? (const char*)g.Bt + (size_t)nxt.pn * tstepB + (size_t)nxt.ks * g.ksB : cB;
        for (int t = 0; t < nt; t += 2) {
            const bool last = (t == nt - 2);
            const char* a1 = cA + (size_t)(t + 1) * kstep;
            const char* a2 = last ? nA : cA + (size_t)(t + 2) * kstep; const char* b2 = last ? nB : cB + (size_t)(t + 2) * kstep;
            const char* a3 = a2 + kstep; const char* b3 = b2 + kstep;
            PG8_LDB(B0, 0, 0); PG8_LDB(B1, 0, 1); PG8_SCHED; PG8_LDA(At, 0, 0); PG8_STAGE(PG8_SA(1, 1), a1 + hstepA, voffA);
            PG8_WAIT_V(8); PG8_WAIT_L(0); PG8_BAR; PG8_MMA(0, 0, At, B0); PG8_MMA(0, 1, At, B1); PG8_BAR; PG8_SCHED;
            PG8_LDA(At, 0, 1); PG8_STAGE(PG8_SB(0, 0), b2, voffB); PG8_STAGE(PG8_SB(0, 1), b2 + hstepB, voffB); PG8_STAGE(PG8_SA(0, 0), a2, voffA);
            PG8_WAIT_V(8); PG8_WAIT_L(0); PG8_BAR; PG8_MMA(1, 0, At, B0); PG8_MMA(1, 1, At, B1); PG8_BAR; PG8_SCHED;
            PG8_LDB(B0, 1, 0); PG8_LDB(B1, 1, 1); PG8_SCHED; PG8_LDA(At, 1, 0); PG8_STAGE(PG8_SA(0, 1), a2 + hstepA, voffA);
            PG8_WAIT_V(8); PG8_WAIT_L(0); PG8_BAR; PG8_MMA(0, 0, At, B0); PG8_MMA(0, 1, At, B1); PG8_BAR; PG8_SCHED;
            PG8_LDA(At, 1, 1); PG8_STAGE(PG8_SB(1, 0), b3, voffB); PG8_STAGE(PG8_SB(1, 1), b3 + hstepB, voffB); PG8_STAGE(PG8_SA(1, 0), a3, voffA);
            PG8_WAIT_V(8); PG8_WAIT_L(0); PG8_BAR; PG8_MMA(1, 0, At, B0); PG8_MMA(1, 1, At, B1); PG8_BAR; PG8_SCHED;
        }
        if (wr == 0) PG8_BAR;
        E(acc, cur, wr, wc, fr, fq);
        if (!has_next) break;
#pragma unroll
        for (int a = 0; a < 2; ++a)
#pragma unroll
            for (int b = 0; b < 2; ++b)
#pragma unroll
                for (int m = 0; m < 4; ++m)
#pragma unroll
                    for (int n = 0; n < 2; ++n) acc[a][b][m][n] = (f32x4){0.f, 0.f, 0.f, 0.f};
        cur = nxt; cA = nA; cB = nB; ++ui;
        if (wr == 1) PG8_BAR;
    }
    PG8_WAIT_V(0);
    PG8_BAR;
#undef PG8_SA
#undef PG8_SB
#undef PG8_STAGE
#undef PG8_LDA
#undef PG8_LDB
#undef PG8_MMA
#undef PG8_WAIT_V
#undef PG8_WAIT_L
#undef PG8_BAR
#undef PG8_SCHED
}

__device__ __forceinline__ u32x4 pack8(const f32x4 v0, const f32x4 v1) { u32x4 w; w.x = cvt_pk_bf16(v0[0], v0[1]); w.y = cvt_pk_bf16(v0[2], v0[3]); w.z = cvt_pk_bf16(v1[0], v1[1]); w.w = cvt_pk_bf16(v1[2], v1[3]); return w; }
__device__ __forceinline__ void unpack8(const u32x4 w, f32x4& v0, f32x4& v1) { v0 = (f32x4){bf_lo(w.x), bf_hi(w.x), bf_lo(w.y), bf_hi(w.y)}; v1 = (f32x4){bf_lo(w.z), bf_hi(w.z), bf_lo(w.w), bf_hi(w.w)}; }

struct EpiQKV {
    bf16_t* rawqk; bf16_t* vbuf;
    __device__ __forceinline__ void operator()(const f32x4 (&acc)[2][2][4][2], const Unit& u, int wr, int wc, int fr, int fq) const {
        int colt = u.pn * BM; bf16_t* base = rawqk; if (colt >= 2048) { base = vbuf; colt -= 2048; }
        const int row0 = 64 + u.pm * BM + wr * 64 + fr, col0 = colt + wc * 32 + 8 * fq;
#pragma unroll
        for (int ai = 0; ai < 2; ++ai)
#pragma unroll
            for (int m = 0; m < 4; ++m) { bf16_t* rowp = base + (size_t)(row0 + ai * HALF + m * 16) * 2048 + col0;
#pragma unroll
                for (int bj = 0; bj < 2; ++bj) *(u32x4*)(rowp + bj * HALF) = pack8(acc[ai][bj][m][0], acc[ai][bj][m][1]); }
    }
};

struct EpiGate {
    bf16_t* H; bf16_t* G2; const float* hss; const float* mg; const float* gg;
    __device__ __forceinline__ void operator()(const f32x4 (&acc)[2][2][4][2], const Unit& u, int wr, int wc, int fr, int fq) const {
        const int row0 = u.pm * BM + wr * 64 + fr;
        if (u.pn >= 8) {
            const int col0 = (u.pn - 8) * BM + wc * 32 + 8 * fq;
#pragma unroll
            for (int ai = 0; ai < 2; ++ai)
#pragma unroll
                for (int m = 0; m < 4; ++m) { bf16_t* rowp = G2 + (size_t)(row0 + ai * HALF + m * 16) * 2048 + col0;
#pragma unroll
                    for (int bj = 0; bj < 2; ++bj) { f32x4 v0 = acc[ai][bj][m][0], v1 = acc[ai][bj][m][1];
#pragma unroll
                        for (int e = 0; e < 4; ++e) { v0[e] = sigmoidf_(v0[e]); v1[e] = sigmoidf_(v1[e]); }
                        *(u32x4*)(rowp + bj * HALF) = pack8(v0, v1); } }
        } else {
            const int br = u.pn >> 2, head = u.pn & 3;
            const float* gain = (br ? gg : mg) + head * 256 + wc * 32 + 8 * fq;
            f32x4 gv[2][2];
#pragma unroll
            for (int bj = 0; bj < 2; ++bj) { gv[bj][0] = *(const f32x4*)(gain + bj * HALF); gv[bj][1] = *(const f32x4*)(gain + bj * HALF + 4); }
            const int col0 = br * 1024 + head * 256 + wc * 32 + 8 * fq;
#pragma unroll
            for (int ai = 0; ai < 2; ++ai)
#pragma unroll
                for (int m = 0; m < 4; ++m) { const int row = row0 + ai * HALF + m * 16;
                    const f32x4 s0 = *(const f32x4*)(hss + (size_t)row * 64 + br * 32 + head * 8), s1 = *(const f32x4*)(hss + (size_t)row * 64 + br * 32 + head * 8 + 4);
                    const float ssum = ((s0[0] + s0[1]) + (s0[2] + s0[3])) + ((s1[0] + s1[1]) + (s1[2] + s1[3]));
                    const float rstd = __builtin_amdgcn_rsqf(ssum * (1.f / 256.f) + EPS);
                    bf16_t* rowp = H + (size_t)row * 2048 + col0;
#pragma unroll
                    for (int bj = 0; bj < 2; ++bj) { f32x4 a0 = acc[ai][bj][m][0], a1 = acc[ai][bj][m][1], h0, h1;
                        unpack8(*(const u32x4*)(rowp + bj * HALF), h0, h1);
#pragma unroll
                        for (int e = 0; e < 4; ++e) { const float g0 = br ? siluf_(a0[e]) : sigmoidf_(a0[e]), g1 = br ? siluf_(a1[e]) : sigmoidf_(a1[e]);
                            h0[e] = h0[e] * rstd * gv[bj][0][e] * g0; h1[e] = h1[e] * rstd * gv[bj][1][e] * g1; }
                        *(u32x4*)(rowp + bj * HALF) = pack8(h0, h1); } }
        }
    }
};

struct EpiMerge {
    bf16_t* MG; const bf16_t* G2;
    __device__ __forceinline__ void operator()(const f32x4 (&acc)[2][2][4][2], const Unit& u, int wr, int wc, int fr, int fq) const {
        const int row0 = u.pm * BM + wr * 64 + fr, col0 = u.pn * BM + wc * 32 + 8 * fq;
#pragma unroll
        for (int ai = 0; ai < 2; ++ai)
#pragma unroll
            for (int m = 0; m < 4; ++m) { const int row = row0 + ai * HALF + m * 16;
                bf16_t* rowp = MG + (size_t)row * 1024 + col0; const bf16_t* gp = G2 + (size_t)row * 2048 + u.ks * 1024 + col0;
#pragma unroll
                for (int bj = 0; bj < 2; ++bj) { f32x4 g0, g1; unpack8(*(const u32x4*)(gp + bj * HALF), g0, g1);
                    f32x4 v0 = acc[ai][bj][m][0] * g0, v1 = acc[ai][bj][m][1] * g1;
                    if (u.ks) { f32x4 p0, p1; unpack8(*(const u32x4*)(rowp + bj * HALF), p0, p1); v0 = v0 + p0; v1 = v1 + p1; }
                    *(u32x4*)(rowp + bj * HALF) = pack8(v0, v1); } }
    }
};

struct EpiResid {
    const float* resid; bf16_t* h1b; float* sumsq;
    __device__ __forceinline__ void operator()(const f32x4 (&acc)[2][2][4][2], const Unit& u, int wr, int wc, int fr, int fq) const {
        const int row0 = u.pm * BM + wr * 64 + fr, col0 = u.pn * BM + wc * 32 + 8 * fq;
#pragma unroll
        for (int ai = 0; ai < 2; ++ai)
#pragma unroll
            for (int m = 0; m < 4; ++m) { const int row = row0 + ai * HALF + m * 16; float ss = 0.f;
#pragma unroll
                for (int bj = 0; bj < 2; ++bj) { const size_t o = (size_t)row * 1024 + col0 + bj * HALF;
                    const f32x4 v0 = *(const f32x4*)(resid + o) + acc[ai][bj][m][0], v1 = *(const f32x4*)(resid + o + 4) + acc[ai][bj][m][1];
                    ss += (v0[0] * v0[0] + v0[1] * v0[1]) + (v0[2] * v0[2] + v0[3] * v0[3]) + (v1[0] * v1[0] + v1[1] * v1[1]) + (v1[2] * v1[2] + v1[3] * v1[3]);
                    *(u32x4*)(h1b + o) = pack8(v0, v1); }
                ss += __shfl_xor(ss, 16); ss += __shfl_xor(ss, 32);
                if (fq == 0) __hip_atomic_fetch_add(sumsq + row, ss, __ATOMIC_RELAXED, __HIP_MEMORY_SCOPE_AGENT); }
    }
};

struct EpiFF {
    bf16_t* FF; const float* sumsq;
    __device__ __forceinline__ void operator()(const f32x4 (&acc)[2][2][4][2], const Unit& u, int wr, int wc, int fr, int fq) const {
        const int row0 = u.pm * BM + wr * 64 + fr, col0 = u.pn * HALF + wc * 32 + 8 * fq;
#pragma unroll
        for (int ai = 0; ai < 2; ++ai)
#pragma unroll
            for (int m = 0; m < 4; ++m) { const int row = row0 + ai * HALF + m * 16;
                const float r = __builtin_amdgcn_rsqf(sumsq[row] * (1.f / 1024.f) + EPS);
                f32x4 v0, v1;
#pragma unroll
                for (int e = 0; e < 4; ++e) { v0[e] = siluf_(r * acc[ai][0][m][0][e]) * (r * acc[ai][1][m][0][e]); v1[e] = siluf_(r * acc[ai][0][m][1][e]) * (r * acc[ai][1][m][1][e]); }
                *(u32x4*)(FF + (size_t)row * DFF + col0) = pack8(v0, v1); }
    }
};

struct EpiFinal {
    float* out; const bf16_t* h1b; const float* fg; float* sumsq; unsigned* cnt;
    __device__ __forceinline__ void operator()(f32x4 (&acc)[2][2][4][2], const Unit& u, int wr, int wc, int fr, int fq) const {
        const int row0 = u.pm * BM + wr * 64 + fr, col0 = u.pn * BM + wc * 32 + 8 * fq;
#pragma unroll
        for (int ai = 0; ai < 2; ++ai)
#pragma unroll
            for (int m = 0; m < 4; ++m) { const int row = row0 + ai * HALF + m * 16; float ss = 0.f;
#pragma unroll
                for (int bj = 0; bj < 2; ++bj) { const size_t o = (size_t)row * 1024 + col0 + bj * HALF;
                    f32x4 r0, r1; unpack8(*(const u32x4*)(h1b + o), r0, r1);
                    const f32x4 v0 = r0 + acc[ai][bj][m][0], v1 = r1 + acc[ai][bj][m][1];
                    acc[ai][bj][m][0] = v0; acc[ai][bj][m][1] = v1;
                    ss += (v0[0] * v0[0] + v0[1] * v0[1]) + (v0[2] * v0[2] + v0[3] * v0[3]) + (v1[0] * v1[0] + v1[1] * v1[1]) + (v1[2] * v1[2] + v1[3] * v1[3]); }
                ss += __shfl_xor(ss, 16); ss += __shfl_xor(ss, 32);
                if (fq == 0) __hip_atomic_fetch_add(sumsq + row, ss, __ATOMIC_RELAXED, __HIP_MEMORY_SCOPE_AGENT); }
        asm volatile("s_waitcnt vmcnt(0)" ::: "memory");
        __syncthreads();
        if (threadIdx.x == 0) {
            __threadfence();
            unsigned* c = cnt + u.pm * 64;
            __hip_atomic_fetch_add(c, 1u, __ATOMIC_RELAXED, __HIP_MEMORY_SCOPE_AGENT);
            unsigned sp = 0;
            while (__hip_atomic_load(c, __ATOMIC_RELAXED, __HIP_MEMORY_SCOPE_AGENT) < 4u) { __builtin_amdgcn_s_sleep(1); if (++sp > (1u << 22)) break; }
            __threadfence();
        }
        __syncthreads();
        f32x4 gv[2][2];
#pragma unroll
        for (int bj = 0; bj < 2; ++bj) { gv[bj][0] = *(const f32x4*)(fg + col0 + bj * HALF); gv[bj][1] = *(const f32x4*)(fg + col0 + bj * HALF + 4); }
#pragma unroll
        for (int ai = 0; ai < 2; ++ai)
#pragma unroll
            for (int m = 0; m < 4; ++m) { const int row = row0 + ai * HALF + m * 16;
                const float ssum = __hip_atomic_load(sumsq + row, __ATOMIC_RELAXED, __HIP_MEMORY_SCOPE_AGENT);
                const float rs = __builtin_amdgcn_rsqf(ssum * (1.f / 1024.f) + EPS);
#pragma unroll
                for (int bj = 0; bj < 2; ++bj) { const size_t o = (size_t)row * 1024 + col0 + bj * HALF;
                    *(f32x4*)(out + o) = acc[ai][bj][m][0] * rs * gv[bj][0]; *(f32x4*)(out + o + 4) = acc[ai][bj][m][1] * rs * gv[bj][1]; } }
    }
};
}


#define XB_TMO      128
#define XB_XCNT(j)  (256  + 64 * (j))
#define XB_XSUB(j)  (1280 + 64 * (j))
#define XB_XGEN(j)  (2304 + 64 * (j))
#define XB_TOP      3328
#define XB_TOPGEN   3392
#define XCD_BAR_WORDS 3456
#define XB_SPIN_CAP (1u << 18)
__device__ __forceinline__ unsigned xb_ld(unsigned* p)              { return __hip_atomic_load(p, __ATOMIC_RELAXED, __HIP_MEMORY_SCOPE_AGENT); }
__device__ __forceinline__ unsigned xb_add(unsigned* p, unsigned v) { return __hip_atomic_fetch_add(p, v, __ATOMIC_RELAXED, __HIP_MEMORY_SCOPE_AGENT); }
__device__ __forceinline__ unsigned xb_xcc_id() { return (unsigned)__builtin_amdgcn_s_getreg((3 << 11) | 20) & 0xFu; }
#define XB_SPIN(cond, bar) do { unsigned _sp = 0; while (cond) { __builtin_amdgcn_s_sleep(1); \
    if ((++_sp & 255u) == 0u) { if (xb_ld(&(bar)[XB_TMO])) break; if (_sp > XB_SPIN_CAP) { atomicAdd(&(bar)[XB_TMO], 1u); break; } } } } while (0)
struct XcdBarrier { unsigned* bar; unsigned x; volatile LAS unsigned* st; };
__device__ __forceinline__ XcdBarrier xcd_barrier_post(unsigned* bar, volatile LAS unsigned* st) {
    XcdBarrier b; b.bar = bar; b.x = xb_xcc_id(); b.st = st;
    if (threadIdx.x == 0) (void)xb_add(&bar[XB_XCNT(b.x)], 1u);
    return b;
}
__device__ __forceinline__ void xcd_barrier_complete(unsigned* bar, unsigned x, unsigned& nloc, unsigned& nx) {
    const unsigned G = gridDim.x * gridDim.y * gridDim.z;
    unsigned sum, cnt, mine, sp = 0u;
    for (;;) {
        sum = 0u; cnt = 0u; mine = 0u;
#pragma unroll
        for (unsigned j = 0; j < 16; ++j) { const unsigned c = xb_ld(&bar[XB_XCNT(j)]); sum += c; cnt += (c > 0u) ? 1u : 0u; mine = (j == x) ? c : mine; }
        if (sum == G) break;
        __builtin_amdgcn_s_sleep(1);
        if ((++sp & 255u) == 0u) { if (xb_ld(&bar[XB_TMO])) break; if (sp > XB_SPIN_CAP) { atomicAdd(&bar[XB_TMO], 1u); break; } }
    }
    nloc = mine > 0u ? mine : 1u; nx = cnt > 0u ? cnt : 1u;
}
__device__ __forceinline__ void xcd_barrier(const XcdBarrier& b) {
    asm volatile("s_waitcnt vmcnt(0)" ::: "memory");
    __syncthreads();
    if (threadIdx.x == 0) {
        unsigned* bar = b.bar;
        __builtin_amdgcn_s_waitcnt(0);
        unsigned nloc = b.st[0], nx = b.st[1];
        if (nloc == 0u) { xcd_barrier_complete(bar, b.x, nloc, nx); b.st[0] = nloc; b.st[1] = nx; }
        const unsigned old = xb_add(&bar[XB_XSUB(b.x)], 1u);
        const unsigned gen = old / nloc;
        if (old + 1u == (gen + 1u) * nloc) {
            __builtin_amdgcn_fence(__ATOMIC_RELEASE, "agent");
            asm volatile("s_waitcnt vmcnt(0)" ::: "memory");
            const unsigned og = xb_add(&bar[XB_TOP], 1u);
            const unsigned tg = og / nx;
            if (og + 1u == (tg + 1u) * nx) xb_add(&bar[XB_TOPGEN], 1u);
            else XB_SPIN(xb_ld(&bar[XB_TOPGEN]) == tg, bar);
            __builtin_amdgcn_fence(__ATOMIC_ACQUIRE, "agent");
            xb_add(&bar[XB_XGEN(b.x)], 1u);
            asm volatile("s_waitcnt vmcnt(0)" ::: "memory");
        } else {
            XB_SPIN(xb_ld(&bar[XB_XGEN(b.x)]) == gen, bar);
            __builtin_amdgcn_fence(__ATOMIC_ACQUIRE, "agent");
            asm volatile("s_waitcnt vmcnt(0)" ::: "memory");
        }
    }
    __syncthreads();
}

struct Params { const float* in[19]; float* out; unsigned char* ws; int ph_lo, ph_hi; };

__device__ __forceinline__ void transpose_item(const float* W, int ldw, int K, bf16_t* WT, int kb, int nb, LAS float* scr, int lane, const float* ksc) {
    const int k0 = 64 * kb, n0 = 32 * nb;
    const float* Wl = W + (size_t)(k0 + (lane >> 5)) * ldw + n0 + (lane & 31);
#pragma unroll
    for (int hh = 0; hh < 2; ++hh) { float tv[16];
#pragma unroll
        for (int i = 0; i < 16; ++i) tv[i] = Wl[(size_t)(2 * (16 * hh + i)) * ldw];
        if (ksc) {
#pragma unroll
            for (int i = 0; i < 16; ++i) tv[i] *= ksc[k0 + 2 * (16 * hh + i) + (lane >> 5)]; }
#pragma unroll
        for (int i = 0; i < 16; ++i) { const int kk = 2 * (16 * hh + i) + (lane >> 5); scr[kk * 33 + (lane & 31)] = tv[i]; } }
    asm volatile("s_waitcnt lgkmcnt(0)" ::: "memory");
    const int c = lane & 7;
#pragma unroll
    for (int j = 0; j < 4; ++j) { const int n = (lane >> 3) + 8 * j; const LAS float* s = scr + (8 * c) * 33 + n;
        u32x4 o; o.x = cvt_pk_bf16(s[0 * 33], s[1 * 33]); o.y = cvt_pk_bf16(s[2 * 33], s[3 * 33]); o.z = cvt_pk_bf16(s[4 * 33], s[5 * 33]); o.w = cvt_pk_bf16(s[6 * 33], s[7 * 33]);
        *(u32x4*)(WT + (size_t)(n0 + n) * K + k0 + 8 * c) = o; }
    asm volatile("s_waitcnt lgkmcnt(0)" ::: "memory");
}

constexpr int TR_NITEMS = 3072 + 1024 + 1536 + 2816 + 1408;
__device__ __forceinline__ void transpose_global_item(const Params& p, int it, LAS float* scr, int lane) {
    unsigned char* ws = p.ws; const float* w_in = p.in[3];
    int r = it; const float* src; int ldw, K = 1024, kb, nb; bf16_t* dst; const float* ksc = nullptr;
    if (r < 3072) { const int pc = r >> 9; r &= 511; kb = r >> 5; nb = r & 31; ldw = NPROJ;
        const int so = pc == 0 ? 0 : pc == 1 ? 3080 : pc == 2 ? 1024 : pc == 3 ? 4104 : pc == 4 ? 2056 : 5144;
        src = w_in + so; dst = (bf16_t*)(ws + (pc < 4 ? WS_WTA : WS_WTB)) + (size_t)(pc < 4 ? pc : pc - 4) * 1048576; }
    else if ((r -= 3072) < 1024) { kb = r >> 6; nb = r & 63; ldw = NPROJ; src = w_in + 6168; dst = (bf16_t*)(ws + WS_WTB) + (size_t)2 * 1048576; }
    else if ((r -= 1024) < 1536) { const int pc = r >> 9; r &= 511; kb = r >> 5; nb = r & 31; ldw = 1024; src = p.in[11 + pc]; dst = (bf16_t*)(ws + WS_WTBM) + (size_t)pc * 1048576; }
    else if ((r -= 1536) < 2816) { const int q = r >> 6; r &= 63; kb = r >> 2; nb = r & 3; const int i = q >> 1, isup = q & 1; ldw = DFF;
        src = p.in[15 + isup] + 128 * i; dst = (bf16_t*)(ws + WS_WTFF) + (size_t)(256 * i + 128 * isup) * 1024; ksc = p.in[14]; }
    else { r -= 2816; kb = r >> 5; nb = r & 31; ldw = 1024; K = DFF; src = p.in[17]; dst = (bf16_t*)(ws + WS_WTD); }
    transpose_item(src, ldw, K, dst, kb, nb, scr, lane, ksc);
}
constexpr int TR_DEF1_LO = 2048, TR_DEF1_HI = 3072;
constexpr int TR_DEF2_LO = 8448;

__device__ __forceinline__ void p0_prologue(const Params& p, LAS unsigned char* L) {
    const int tid = threadIdx.x, lane = tid & 63, wave = __builtin_amdgcn_readfirstlane(tid >> 6);
    const int G = gridDim.x, gw = blockIdx.x * 8 + wave, NGW = G * 8;
    unsigned char* ws = p.ws;
    const float* w_in = p.in[3];
    {
        LAS float* scr = (LAS float*)(L + wave * 8448);
        if (G == 256) { constexpr int NV = TR_NITEMS - (TR_DEF1_HI - TR_DEF1_LO) - (TR_NITEMS - TR_DEF2_LO);
            for (int v = gw; v < NV; v += NGW) transpose_global_item(p, v < TR_DEF1_LO ? v : v + (TR_DEF1_HI - TR_DEF1_LO), scr, lane); }
        else { for (int it = gw; it < TR_NITEMS; it += NGW) transpose_global_item(p, it, scr, lane); }
    }
    __syncthreads();
    {
        LAS float* xT = (LAS float*)L;
        LAS float* red = (LAS float*)(L + 65536);
#pragma unroll
        for (int rr = 0; rr < 2; ++rr) { const int row = 2 * wave + rr; const f32x4* xr = (const f32x4*)(p.in[1] + (size_t)row * 1024) + lane; const f32x4* gr = (const f32x4*)p.in[2] + lane;
            f32x4 v[4]; float s = 0.f;
#pragma unroll
            for (int j = 0; j < 4; ++j) { v[j] = xr[64 * j]; s += (v[j][0] * v[j][0] + v[j][1] * v[j][1]) + (v[j][2] * v[j][2] + v[j][3] * v[j][3]); }
            const float rstd = __builtin_amdgcn_rsqf(wave_sum(s) * (1.f / 1024.f) + EPS);
#pragma unroll
            for (int j = 0; j < 4; ++j) { const f32x4 gq = gr[64 * j];
#pragma unroll
                for (int e = 0; e < 4; ++e) xT[(256 * j + 4 * lane + e) * 16 + row] = v[j][e] * rstd * gq[e]; } }
        __syncthreads();
        for (int cg0 = blockIdx.x * 16; cg0 < 4096; cg0 += G * 16) {
            const int ci = lane & 15, kq = lane >> 4, dcol = cg0 + ci;
            const int scol = dcol < 1024 ? dcol : dcol < 2048 ? 3080 + (dcol - 1024) : dcol < 3072 ? 1024 + (dcol - 2048) : 4104 + (dcol - 3072);
            float a[16];
#pragma unroll
            for (int r = 0; r < 16; ++r) a[r] = 0.f;
            const int kbase = 128 * wave + kq;
            const float* wp = w_in + (size_t)kbase * NPROJ + scol;
#pragma unroll
            for (int ib = 0; ib < 2; ++ib) { float wv[16];
#pragma unroll
                for (int i = 0; i < 16; ++i) wv[i] = wp[(size_t)(4 * (16 * ib + i)) * NPROJ];
#pragma unroll
                for (int i = 0; i < 16; ++i) { const LAS f32x4* xp = (const LAS f32x4*)(xT + (kbase + 4 * (16 * ib + i)) * 16);
#pragma unroll
                    for (int q = 0; q < 4; ++q) { const f32x4 xv = xp[q];
#pragma unroll
                        for (int e = 0; e < 4; ++e) a[4 * q + e] += xv[e] * wv[i]; }
                    __builtin_amdgcn_sched_barrier(0); } }
#pragma unroll
            for (int r = 0; r < 16; ++r) { a[r] += __shfl_xor(a[r], 16); a[r] += __shfl_xor(a[r], 32); }
            if (kq == 0) {
#pragma unroll
                for (int r = 0; r < 16; ++r) red[(wave * 16 + r) * 16 + ci] = a[r]; }
            __syncthreads();
            if (tid < 256) { const int row = tid >> 4, cc = tid & 15, dc = cg0 + cc; float sm = 0.f;
#pragma unroll
                for (int w = 0; w < 8; ++w) sm += red[(w * 16 + row) * 16 + cc];
                bf16_t* dst = dc < 2048 ? (bf16_t*)(ws + WS_R1) + (size_t)(48 + row) * 2048 + dc : (bf16_t*)(ws + WS_R2) + (size_t)(48 + row) * 2048 + (dc - 2048);
                *dst = f2bf(sm); }
            __syncthreads();
        }
    }
    {
        LAS float* Wsm = (LAS float*)L;
#pragma unroll
        for (int b0 = 0; b0 < 48; b0 += 16) { float tv[16];
#pragma unroll
            for (int i = 0; i < 16; ++i) { const int idx = tid + 512 * (b0 + i); const int k = idx / 24, c = idx - k * 24; const int sc = c < 8 ? 2048 + c : 5128 + (c - 8); tv[i] = w_in[(size_t)k * NPROJ + sc]; }
#pragma unroll
            for (int i = 0; i < 16; ++i) { const int idx = tid + 512 * (b0 + i); const int k = idx / 24, c = idx - k * 24; Wsm[c * 1028 + k] = tv[i]; } }
        __syncthreads();
        float* GI = (float*)(ws + WS_GI); float* GF = (float*)(ws + WS_GF); float* GA = (float*)(ws + WS_GA);
        bf16_t* XN = (bf16_t*)((unsigned char*)p.out + OUT_XN);
        const float bsel = lane < 8 ? p.in[6][lane] : 0.f;
        const f32x4* gr = (const f32x4*)p.in[2] + lane;
        f32x4 g1v[4];
#pragma unroll
        for (int j = 0; j < 4; ++j) g1v[j] = gr[64 * j];
        f32x4 vn[4];
        { const int r = gw; const f32x4* xr = (const f32x4*)(r >= SEQ ? p.in[1] + (size_t)(r - SEQ) * 1024 : p.in[0] + (size_t)r * 1024) + lane;
#pragma unroll
            for (int j = 0; j < 4; ++j) vn[j] = (r < SEQ + 16) ? xr[64 * j] : (f32x4){0.f, 0.f, 0.f, 0.f}; }
        for (int r = gw; r < SEQ + 16; r += NGW) {
            const bool ismeta = r >= SEQ; const int t = ismeta ? 48 + (r - SEQ) : 64 + r;
            f32x4 v[4]; float s = 0.f;
#pragma unroll
            for (int j = 0; j < 4; ++j) { v[j] = vn[j]; s += (v[j][0] * v[j][0] + v[j][1] * v[j][1]) + (v[j][2] * v[j][2] + v[j][3] * v[j][3]); }
            { const int r2 = r + NGW; if (r2 < SEQ + 16) { const f32x4* xr = (const f32x4*)(r2 >= SEQ ? p.in[1] + (size_t)(r2 - SEQ) * 1024 : p.in[0] + (size_t)r2 * 1024) + lane;
#pragma unroll
                for (int j = 0; j < 4; ++j) vn[j] = xr[64 * j]; } }
            const float rstd = __builtin_amdgcn_rsqf(wave_sum(s) * (1.f / 1024.f) + EPS);
#pragma unroll
            for (int j = 0; j < 4; ++j) v[j] = v[j] * rstd * g1v[j];
            if (!ismeta) { u32x2* o8 = (u32x2*)(XN + (size_t)r * 1024) + lane;
#pragma unroll
                for (int j = 0; j < 4; ++j) { u32x2 o; o.x = cvt_pk_bf16(v[j][0], v[j][1]); o.y = cvt_pk_bf16(v[j][2], v[j][3]); o8[64 * j] = o; } }
            float mine = 0.f;
#pragma unroll 4
            for (int c = 0; c < 24; ++c) { float d = 0.f;
#pragma unroll
                for (int j = 0; j < 4; ++j) { const f32x4 wv = *(const LAS f32x4*)(Wsm + c * 1028 + 256 * j + 4 * lane); d += (v[j][0] * wv[0] + v[j][1] * wv[1]) + (v[j][2] * wv[2] + v[j][3] * wv[3]); }
                d = wave_sum(d); if (lane == c) mine = d; }
            if (lane < 4) GI[t * 4 + lane] = mine + bsel;
            else if (lane < 8) GF[t * 4 + lane - 4] = logsigmoidf_(mine + bsel);
            else if (lane < 24) GA[t * 16 + lane - 8] = mine;
        }
    }
}

constexpr int XL_AQ = 0, XL_BK = 17408, XL_KT = 34816, XL_F = 53248;
template <bool SINGLE>
__device__ __forceinline__ void x_phase(const Params& p, LAS unsigned char* L, const int item0, const int NIT, const int GS) {
    const int tid = threadIdx.x, lane = tid & 63, wave = __builtin_amdgcn_readfirstlane(tid >> 6), fr = lane & 15, fq = lane >> 4;
    unsigned char* ws = p.ws;
    const bf16_t* RAW = (const bf16_t*)(ws + WS_R1);
    bf16_t* AQ = (bf16_t*)(ws + WS_AQ); bf16_t* KU = (bf16_t*)(ws + WS_KU); bf16_t* WW = (bf16_t*)((unsigned char*)p.out + OUT_WW);
    const float* GI = (const float*)(ws + WS_GI); const float* GF = (const float*)(ws + WS_GF); const float* GA = (const float*)(ws + WS_GA);
    float* CHB = (float*)(ws + WS_CHB); float* CHM = (float*)(ws + WS_CHM); float* CHG = (float*)(ws + WS_CHG); float* BT = (float*)(ws + WS_BT);
    LAS bf16_t* sAq = (LAS bf16_t*)(L + XL_AQ); LAS bf16_t* sBk = (LAS bf16_t*)(L + XL_BK); LAS bf16_t* sKt = (LAS bf16_t*)(L + XL_KT);
    LAS float* sF = (LAS float*)(L + XL_F);
    LAS float* sga = sF + 256;
    LAS float* part = sF + 256 + 1024;
    const float NINF = -__builtin_inff();
#define X_DECODE(item, c, br, h) const int c = (item) >> 3, br = (((item) >> 2) ^ (c >> 5)) & 1, h = (item) & 3
    const int which = tid >> 8, u = tid & 255, d8 = (u & 15) * 8, l0 = (u >> 4) * 4;
    const int gd = tid & 127, grp = tid >> 7;
    u32x4 raw[7]; float glf = 0.f, gli = 0.f;
    bf16_t rq[16], rk[16]; f32x4 gav = (f32x4){0.f, 0.f, 0.f, 0.f};
#define X_LOAD_M(c, h) do { const int _t0 = (c) * 64; const bf16_t* _src = RAW + which * 512 + (h) * 128 + d8; \
        _Pragma("unroll") for (int _i = 0; _i < 7; ++_i) { const int _t = _t0 + l0 - 3 + _i; raw[_i] = (_t >= 48) ? *(const u32x4*)(_src + (size_t)_t * 2048) : (u32x4){0u, 0u, 0u, 0u}; } \
        if (wave >= 4) { const int _t = _t0 + lane; const bool _v = _t >= 48; glf = _v ? GF[_t * 4 + (h)] : 0.f; gli = _v ? GI[_t * 4 + (h)] : NINF; } } while (0)
#define X_LOAD_G(c, h) do { const int _t0 = (c) * 64; const int _col = (h) * 128 + gd; \
        if (tid < 256) gav = ((const f32x4*)(GA + (size_t)_t0 * 16))[tid]; \
        _Pragma("unroll") for (int _i = 0; _i < 16; ++_i) { const int _t = _t0 + grp * 16 + _i; rq[_i] = (_t >= 48) ? RAW[(size_t)_t * 2048 + 1024 + _col] : (bf16_t)0; rk[_i] = (_t >= 48) ? RAW[(size_t)_t * 2048 + 1536 + _col] : (bf16_t)0; } } while (0)

    int item = item0;
    if (item < NIT) { X_DECODE(item, c, br, h); if (br == 0) X_LOAD_M(c, h); else X_LOAD_G(c, h); }
    bool need = false;
    for (; item < NIT; item += (SINGLE ? NIT : GS)) {
        X_DECODE(item, c, br, h); const int t0 = c * 64, ix = c * 8 + br * 4 + h;
        if (need) { if (br == 0) X_LOAD_M(c, h); else X_LOAD_G(c, h); }
        need = false;
        if (!SINGLE) { const int nx = item + GS; if (nx < NIT) { X_DECODE(nx, c2, br2, h2); if (br2 != br) { if (br2 == 0) X_LOAD_M(c2, h2); else X_LOAD_G(c2, h2); } else need = true; } }
        if (br == 0) {
            const int ch0 = which * 512 + h * 128 + d8;
            const float* cw = p.in[4] + ch0; const float* cb = p.in[5] + ch0;
            f32x4 wv4[4][2];
#pragma unroll
            for (int j = 0; j < 4; ++j) { wv4[j][0] = *(const f32x4*)(cw + j * 1024); wv4[j][1] = *(const f32x4*)(cw + j * 1024 + 4); }
            const f32x4 bv0 = *(const f32x4*)cb, bv1 = *(const f32x4*)(cb + 4);
            if (wave >= 4) {
                const float lf = glf, li = gli;
                const float b = wave_scan_sum(lf);
                const float gtot = __int_as_float(__builtin_amdgcn_readlane(__float_as_int(b), 63));
                const float wl = gtot - b + li;
                const float Ml = wave_max(wl);
                const float e = __expf(wl - Ml);
                const float lib = li - b;
                const float pm = wave_scan_max(lib);
                const bool dead = (pm == NINF);
                sF[128 + 64 * (wave - 4) + lane] = e;
                if (wave == 4) {
                    sF[lane] = lib; sF[64 + lane] = dead ? 0.f : pm;
                    CHB[(c * 4 + h) * 64 + lane] = b; CHM[(c * 4 + h) * 64 + lane] = dead ? 0.f : (b + pm);
                    if (lane == 0) { CHG[(c * 4 + h) * 2] = gtot; CHG[(c * 4 + h) * 2 + 1] = Ml; } }
                asm volatile("s_waitcnt lgkmcnt(0)" ::: "memory");
            }
            {
                float res[4][8];
#pragma unroll
                for (int e2 = 0; e2 < 4; ++e2) {
#pragma unroll
                    for (int o = 0; o < 4; ++o) { float y0 = e2 < 2 ? bv0[2 * e2] : bv1[2 * e2 - 4], y1 = e2 < 2 ? bv0[2 * e2 + 1] : bv1[2 * e2 - 3];
#pragma unroll
                        for (int j = 0; j < 4; ++j) { const unsigned wv = raw[o + j][e2]; y0 += (e2 < 2 ? wv4[j][0][2 * e2] : wv4[j][1][2 * e2 - 4]) * bf_lo(wv); y1 += (e2 < 2 ? wv4[j][0][2 * e2 + 1] : wv4[j][1][2 * e2 - 3]) * bf_hi(wv); }
                        res[o][2 * e2] = siluf_(y0); res[o][2 * e2 + 1] = siluf_(y1); } }
                if (which == 0) {
#pragma unroll
                    for (int o = 0; o < 4; ++o) { u32x4 w; w.x = cvt_pk_bf16(res[o][0] * QSCALE, res[o][1] * QSCALE); w.y = cvt_pk_bf16(res[o][2] * QSCALE, res[o][3] * QSCALE);
                        w.z = cvt_pk_bf16(res[o][4] * QSCALE, res[o][5] * QSCALE); w.w = cvt_pk_bf16(res[o][6] * QSCALE, res[o][7] * QSCALE);
                        *(LAS u32x4*)(sAq + (l0 + o) * 136 + d8) = w; *(u32x4*)(AQ + (size_t)(t0 + l0 + o) * 1024 + h * 128 + d8) = w; }
                } else {
                    float ev[4];
#pragma unroll
                    for (int o = 0; o < 4; ++o) { ev[o] = sF[128 + 64 * (wave - 4) + l0 + o];
                        u32x4 w; w.x = cvt_pk_bf16(res[o][0], res[o][1]); w.y = cvt_pk_bf16(res[o][2], res[o][3]); w.z = cvt_pk_bf16(res[o][4], res[o][5]); w.w = cvt_pk_bf16(res[o][6], res[o][7]);
                        *(LAS u32x4*)(sBk + (l0 + o) * 136 + d8) = w; }
#pragma unroll
                    for (int e = 0; e < 8; ++e) { u32x2 w; w.x = cvt_pk_bf16(res[0][e] * ev[0], res[1][e] * ev[1]); w.y = cvt_pk_bf16(res[2][e] * ev[2], res[3][e] * ev[3]);
                        *(LAS u32x2*)(sKt + (d8 + e) * 72 + l0) = w; }
                }
            }
        } else {
            const int d = gd, col = h * 128 + d;
            float a2[16];
#pragma unroll
            for (int r = 0; r < 16; ++r) a2[r] = p.in[7][r * 512 + col];
            const float bias = p.in[8][col];
            if (tid < 256) ((LAS f32x4*)sga)[tid] = gav;
            LDS_BARRIER();
            float cs[16]; float run = 0.f;
#pragma unroll
            for (int i = 0; i < 16; ++i) { const int l = grp * 16 + i; float za = bias;
#pragma unroll
                for (int q = 0; q < 4; ++q) { const f32x4 gv = *(const LAS f32x4*)(sga + l * 16 + 4 * q); za += (gv[0] * a2[4 * q] + gv[1] * a2[4 * q + 1]) + (gv[2] * a2[4 * q + 2] + gv[3] * a2[4 * q + 3]); }
                const float la = (t0 + l >= 48) ? logsigmoidf_(za) * (1.f / 16.f) : 0.f;
                run += la; cs[i] = run; }
            part[grp * 128 + d] = run;
            LDS_BARRIER();
            float off = 0.f, btot = 0.f;
#pragma unroll
            for (int g2 = 0; g2 < 4; ++g2) { const float pv = part[g2 * 128 + d]; btot += pv; if (g2 < grp) off += pv; }
            if (grp == 0) BT[(c * 4 + h) * 128 + d] = btot;
            float kend[16];
#pragma unroll
            for (int i = 0; i < 16; ++i) { const int l = grp * 16 + i, t = t0 + l; const float bc = cs[i] + off;
                const float gq = bf2f(rq[i]), gk = bf2f(rk[i]);
                const bf16_t qd = f2bf(gq * QSCALE * __expf(bc));
                sAq[l * 136 + d] = qd; AQ[(size_t)t * 1024 + 512 + col] = qd;
                sBk[l * 136 + d] = f2bf(gk * __expf(-bc));
                kend[i] = gk * __expf(btot - bc); }
            u32x4 w0, w1;
            w0.x = cvt_pk_bf16(kend[0], kend[1]); w0.y = cvt_pk_bf16(kend[2], kend[3]); w0.z = cvt_pk_bf16(kend[4], kend[5]); w0.w = cvt_pk_bf16(kend[6], kend[7]);
            w1.x = cvt_pk_bf16(kend[8], kend[9]); w1.y = cvt_pk_bf16(kend[10], kend[11]); w1.z = cvt_pk_bf16(kend[12], kend[13]); w1.w = cvt_pk_bf16(kend[14], kend[15]);
            *(LAS u32x4*)(sKt + d * 72 + grp * 16) = w0; *(LAS u32x4*)(sKt + d * 72 + grp * 16 + 8) = w1;
        }
        LDS_BARRIER();
        {
            const int jt = wave & 3, sh = wave >> 2, j = jt * 16 + fr;
            const float pmj = br == 0 ? sF[64 + j] : 0.f;
#pragma unroll
            for (int q = 0; q < 2; ++q) { const int st = 2 * sh + q;
                f32x4 acc = (f32x4){0.f, 0.f, 0.f, 0.f};
                if (st <= jt) {
#pragma unroll
                    for (int ks = 0; ks < 4; ++ks) { const bf16x8 kf = *(const LAS bf16x8*)(sBk + (st * 16 + fr) * 136 + ks * 32 + fq * 8), qf = *(const LAS bf16x8*)(sAq + j * 136 + ks * 32 + fq * 8);
                        acc = MFMA16(kf, qf, acc); }
#pragma unroll
                    for (int i = 0; i < 4; ++i) { const int s2 = st * 16 + fq * 4 + i; float dd = 0.f; if (s2 <= j) dd = br == 0 ? __expf(sF[s2] - pmj) : 1.f; acc[i] = (s2 <= j) ? acc[i] * dd : 0.f; }
                }
                u32x2 w; w.x = cvt_pk_bf16(acc[0], acc[1]); w.y = cvt_pk_bf16(acc[2], acc[3]);
                *(u32x2*)(WW + (size_t)ix * 4096 + j * 64 + st * 16 + fq * 4) = w; }
        }
#pragma unroll
        for (int i = 0; i < 2; ++i) { const int pc = tid + 512 * i, row = pc >> 3, sg = pc & 7;
            *(u32x4*)(KU + (size_t)ix * 8192 + pc * 8) = *(const LAS u32x4*)(sKt + row * 72 + sg * 8); }
        LDS_BARRIER();
    }
#undef X_DECODE
#undef X_LOAD_M
#undef X_LOAD_G
}

constexpr int SL_AQ = 0, SL_W = 17408, SL_KT = 26624, SL_VT = 45056, SL_CB = 56576, SL_CH = 78336, SL_ROW = 80896;
template <bool ML, bool PASSC>
__device__ __forceinline__ void scan_item(const Params& p, LAS unsigned char* L, const int qid, const int h, const int sl, const int g) {
    constexpr int NVT = ML ? 5 : 4, NT = ML ? 3 : 2;
    constexpr int NG = PASSC ? 2 : 4, TG = 512 / NG;
    constexpr int NLQ = 1024 / TG, NLW = 512 / TG, NLK = 1024 / TG, NLV = 512 / TG;
    const int tid = threadIdx.x, lane = tid & 63, wave = __builtin_amdgcn_readfirstlane(tid >> 6), fr = lane & 15, fq = lane >> 4;
    const int br = ML ? 0 : 1; const int item = qid * 4 + sl;
    const int gi = wave / (8 / NG), gt = tid & (TG - 1);
    unsigned char* ws = p.ws;
    const bf16_t* AQ = (const bf16_t*)(ws + WS_AQ); const bf16_t* KU = (const bf16_t*)(ws + WS_KU); const bf16_t* WW = (const bf16_t*)((const unsigned char*)p.out + OUT_WW);
    const bf16_t* V = (const bf16_t*)(ws + WS_R2); bf16_t* H = (bf16_t*)(ws + WS_R1); float* HSS = (float*)(ws + WS_HSS);
    const float* CHB = (const float*)(ws + WS_CHB); const float* CHM = (const float*)(ws + WS_CHM); const float* CHG = (const float*)(ws + WS_CHG); const float* BT = (const float*)(ws + WS_BT);
    f32x4* SEG = (f32x4*)(ws + WS_SEG);
    LAS bf16_t* sAq = (LAS bf16_t*)(L + SL_AQ); LAS bf16_t* sW = (LAS bf16_t*)(L + SL_W); LAS bf16_t* sKt = (LAS bf16_t*)(L + SL_KT);
    LAS bf16_t* sVt = (LAS bf16_t*)(L + SL_VT); LAS bf16_t* sCb = (LAS bf16_t*)(L + SL_CB); LAS float* sCH = (LAS float*)(L + SL_CH); LAS float* sRow = (LAS float*)(L + SL_ROW);
    const int cs = seg_start_b(ML, g), ce = seg_start_b(ML, g + 1);
    const int dt = wave, jt = wave & 3, vh = wave >> 2;

    u32x4 rq[NLQ], rw[NLW], rk[NLK], rv[NLV]; float rs = 0.f;
#define SCAN_LOAD(c) do { const int _t0 = (c) * 64; const int _ix = (c) * 8 + br * 4 + h; \
        if (PASSC) { _Pragma("unroll") for (int _i = 0; _i < NLQ; ++_i) { const int _p = gt + TG * _i; rq[_i] = *(const u32x4*)(AQ + (size_t)(_t0 + (_p >> 4)) * 1024 + br * 512 + h * 128 + (_p & 15) * 8); } \
            _Pragma("unroll") for (int _i = 0; _i < NLW; ++_i) rw[_i] = *(const u32x4*)(WW + (size_t)_ix * 4096 + (gt + TG * _i) * 8); } \
        _Pragma("unroll") for (int _i = 0; _i < NLK; ++_i) rk[_i] = *(const u32x4*)(KU + (size_t)_ix * 8192 + (gt + TG * _i) * 8); \
        _Pragma("unroll") for (int _i = 0; _i < NLV; ++_i) { const int _p = gt + TG * _i, _l = _p & 63, _pc = _p >> 6; \
            rv[_i] = (_t0 + _l >= 48) ? *(const u32x4*)(V + (size_t)(_t0 + _l) * 2048 + br * 1024 + h * 256 + sl * 64 + _pc * 8) : (u32x4){0u, 0u, 0u, 0u}; } \
        if (gt < 128) { if (ML) { if (PASSC) rs = (gt < 64) ? CHB[((c) * 4 + h) * 64 + gt] : CHM[((c) * 4 + h) * 64 + gt - 64]; } \
        else rs = BT[(size_t)((c) * 4 + h) * 128 + gt]; } } while (0)
#define SCAN_WRITE() do { \
        if (PASSC) { _Pragma("unroll") for (int _i = 0; _i < NLQ; ++_i) { const int _p = gt + TG * _i; *(LAS u32x4*)(sAq + (_p >> 4) * 136 + (_p & 15) * 8) = rq[_i]; } \
            _Pragma("unroll") for (int _i = 0; _i < NLW; ++_i) { const int _p = gt + TG * _i; *(LAS u32x4*)(sW + (_p >> 3) * 72 + (_p & 7) * 8) = rw[_i]; } } \
        _Pragma("unroll") for (int _i = 0; _i < NLK; ++_i) { const int _p = gt + TG * _i; *(LAS u32x4*)(sKt + (_p >> 3) * 72 + (_p & 7) * 8) = rk[_i]; } \
        _Pragma("unroll") for (int _i = 0; _i < NLV; ++_i) { const int _p = gt + TG * _i, _l = _p & 63, _pc = _p >> 6; \
            _Pragma("unroll") for (int _e = 0; _e < 4; ++_e) { const unsigned _wv = rv[_i][_e]; sVt[(_pc * 8 + 2 * _e) * 72 + _l] = (bf16_t)(_wv & 0xffffu); sVt[(_pc * 8 + 2 * _e + 1) * 72 + _l] = (bf16_t)(_wv >> 16); } } \
        if ((!ML || PASSC) && gt < 128) sRow[gt] = rs; } while (0)
#pragma unroll
    for (int k = 0; k < NG; ++k) { if (gi == k && cs + k < ce) SCAN_LOAD(cs + k); }

    if (ML) { if (tid < 128) { const int row = 64 + (tid >> 3), sg = tid & 7; const unsigned one = (row == 64) ? 0x3F803F80u : 0u; *(LAS u32x4*)(sVt + row * 72 + sg * 8) = (u32x4){one, one, one, one}; }
        for (int i = tid; i < NCH * 2; i += 512) sCH[i] = CHG[(i >> 1) * 8 + h * 2 + (i & 1)]; }
    LDS_BARRIER();

    f32x4 st[NVT];
#pragma unroll
    for (int vt = 0; vt < NVT; ++vt) st[vt] = (f32x4){0.f, 0.f, 0.f, 0.f};
    float mrun = 0.f; f32x4 btacc = (f32x4){0.f, 0.f, 0.f, 0.f};
    for (int gp = 0; gp < g; ++gp) {
        const int c0 = seg_start_b(ML, gp), c1 = seg_start_b(ML, gp + 1);
        f32x4 F;
        if (ML) { float Fl = 0.f;
#pragma unroll 8
            for (int c = c0; c < c1; ++c) { const float gc = sCH[2 * c], Ml = sCH[2 * c + 1]; const float mn = fmaxf(gc + mrun, Ml); Fl += gc + mrun - mn; mrun = mn; }
            const float f = __expf(Fl); F = (f32x4){f, f, f, f}; }
        else { f32x4 s4 = (f32x4){0.f, 0.f, 0.f, 0.f}; if (PASSC) s4 = *(const f32x4*)((const float*)(ws + WS_SEGBT) + (size_t)(h * 8 + gp) * 128 + dt * 16 + fq * 4);
            F = (f32x4){__expf(s4[0]), __expf(s4[1]), __expf(s4[2]), __expf(s4[3])}; }
        if (PASSC) { const int it2 = (qid - g + gp) * 4 + sl;
#pragma unroll
            for (int vt = 0; vt < NVT; ++vt) { const f32x4 Lv = SEG[((size_t)(it2 * 8 + dt) * 5 + vt) * 64 + lane]; st[vt] = F * st[vt] + Lv; } }
    }
    if (PASSC) {
#pragma unroll
        for (int vt = 0; vt < NVT; ++vt) { u32x2 w; w.x = cvt_pk_bf16(st[vt][0], st[vt][1]); w.y = cvt_pk_bf16(st[vt][2], st[vt][3]); *(LAS u32x2*)(sCb + (vt * 16 + fr) * 136 + dt * 16 + fq * 4) = w; }
    }

    for (int c = cs; c < ce; ++c) {
        if (gi == ((c - cs) & (NG - 1))) { SCAN_WRITE(); if (c + NG < ce) SCAN_LOAD(c + NG); }
        LDS_BARRIER();
        float a_c = 1.f, u_c = 1.f, a_int = 1.f, r_int = 1.f, clampv = 1.f; f32x4 dec = (f32x4){1.f, 1.f, 1.f, 1.f};
        if (ML) { const float gc = sCH[2 * c], Ml = sCH[2 * c + 1]; const float mn = fmaxf(gc + mrun, Ml); a_c = __expf(gc + mrun - mn); u_c = __expf(Ml - mn);
            if (PASSC && c > 0) { const float bj = sRow[jt * 16 + fr], mr = sRow[64 + jt * 16 + fr]; const float mrow = fmaxf(bj + mrun, mr);
                a_int = __expf(bj + mrun - mrow); r_int = __expf(mr - mrow); clampv = __expf(-mrow); }
            mrun = mn; }
        else { const f32x4 b4 = *(const LAS f32x4*)(sRow + dt * 16 + fq * 4); dec = (f32x4){__expf(b4[0]), __expf(b4[1]), __expf(b4[2]), __expf(b4[3])}; btacc += b4; }
        if (PASSC && c > 0) {
            f32x4 ai[NT], ae[NT];
#pragma unroll
            for (int q = 0; q < NT; ++q) { ai[q] = (f32x4){0.f, 0.f, 0.f, 0.f}; ae[q] = (f32x4){0.f, 0.f, 0.f, 0.f}; }
#pragma unroll
            for (int ks = 0; ks < 2; ++ks) { const bf16x8 wf = *(const LAS bf16x8*)(sW + (jt * 16 + fr) * 72 + ks * 32 + fq * 8);
#pragma unroll
                for (int q = 0; q < NT; ++q) { const int vt = q < 2 ? 2 * vh + q : 4; const bf16x8 vf = *(const LAS bf16x8*)(sVt + (vt * 16 + fr) * 72 + ks * 32 + fq * 8); ai[q] = MFMA16(vf, wf, ai[q]); } }
#pragma unroll
            for (int ks = 0; ks < 4; ++ks) { const bf16x8 af = *(const LAS bf16x8*)(sAq + (jt * 16 + fr) * 136 + ks * 32 + fq * 8);
#pragma unroll
                for (int q = 0; q < NT; ++q) { const int vt = q < 2 ? 2 * vh + q : 4; const bf16x8 cf = *(const LAS bf16x8*)(sCb + (vt * 16 + fr) * 136 + ks * 32 + fq * 8); ae[q] = MFMA16(cf, af, ae[q]); } }
            float dn = 1.f;
            if (ML) { const float denv = a_int * ae[NT - 1][0] + r_int * ai[NT - 1][0]; const float den = __shfl(denv, fr); dn = __builtin_amdgcn_rcpf(fmaxf(fabsf(den), clampv)); }
            const int row = (c - 1) * 64 + jt * 16 + fr; float ss = 0.f;
#pragma unroll
            for (int q = 0; q < 2; ++q) { f32x4 hv;
#pragma unroll
                for (int i = 0; i < 4; ++i) { hv[i] = ML ? (a_int * ae[q][i] + r_int * ai[q][i]) * dn : (ae[q][i] + ai[q][i]); ss += hv[i] * hv[i]; }
                u32x2 w; w.x = cvt_pk_bf16(hv[0], hv[1]); w.y = cvt_pk_bf16(hv[2], hv[3]);
                *(u32x2*)(H + (size_t)row * 2048 + br * 1024 + h * 256 + sl * 64 + (2 * vh + q) * 16 + fq * 4) = w; }
            ss += __shfl_xor(ss, 16); ss += __shfl_xor(ss, 32);
            if (fq == 0) HSS[(size_t)row * 64 + br * 32 + h * 8 + sl * 2 + vh] = ss;
        }
        f32x4 dl[NVT];
#pragma unroll
        for (int vt = 0; vt < NVT; ++vt) dl[vt] = (f32x4){0.f, 0.f, 0.f, 0.f};
#pragma unroll
        for (int ks = 0; ks < 2; ++ks) { const bf16x8 kf = *(const LAS bf16x8*)(sKt + (dt * 16 + fr) * 72 + ks * 32 + fq * 8);
#pragma unroll
            for (int vt = 0; vt < NVT; ++vt) { const bf16x8 vf = *(const LAS bf16x8*)(sVt + (vt * 16 + fr) * 72 + ks * 32 + fq * 8); dl[vt] = MFMA16(kf, vf, dl[vt]); } }
        LDS_BARRIER();
#pragma unroll
        for (int vt = 0; vt < NVT; ++vt) { if (ML) st[vt] = st[vt] * a_c + dl[vt] * u_c; else st[vt] = st[vt] * dec + dl[vt];
            if (PASSC) { u32x2 w; w.x = cvt_pk_bf16(st[vt][0], st[vt][1]); w.y = cvt_pk_bf16(st[vt][2], st[vt][3]); *(LAS u32x2*)(sCb + (vt * 16 + fr) * 136 + dt * 16 + fq * 4) = w; } }
    }
#undef SCAN_LOAD
#undef SCAN_WRITE
    if (!PASSC) {
#pragma unroll
        for (int vt = 0; vt < NVT; ++vt) SEG[((size_t)(item * 8 + dt) * 5 + vt) * 64 + lane] = st[vt];
        if (!ML && sl == 0 && fr == 0) *(f32x4*)((float*)(ws + WS_SEGBT) + (size_t)(h * 8 + g) * 128 + dt * 16 + fq * 4) = btacc;
    }
    LDS_BARRIER();
}

__device__ __forceinline__ void scan_phase(const Params& p, LAS unsigned char* L, const bool passC) {
    for (int b = blockIdx.x; b < 256; b += gridDim.x) {
        const int x = b & 7, y = b >> 3, qid = x + 8 * (y >> 2), sl = y & 3;
        const bool ml = qid < 4 * NSEG_M;
        const int qq = ml ? qid : qid - 4 * NSEG_M, ns = ml ? NSEG_M : NSEG_G, h = qq / ns, g = qq - h * ns;
        if (!passC && g == ns - 1) continue;
        if (passC) { if (ml) scan_item<true, true>(p, L, qid, h, sl, g); else scan_item<false, true>(p, L, qid, h, sl, g); }
        else { if (ml) scan_item<true, false>(p, L, qid, h, sl, g); else scan_item<false, false>(p, L, qid, h, sl, g); }
    }
}

__global__ void __launch_bounds__(512, 2) fwd_megakernel(Params p) {
    extern __shared__ __attribute__((aligned(16))) unsigned char lds_raw[];
    LAS unsigned char* L = (LAS unsigned char*)lds_raw;
    cg::grid_group grid = cg::this_grid();
    const int lo = p.ph_lo, hi = p.ph_hi, G = gridDim.x;
    unsigned char* ws = p.ws;
#define IN(k) (lo <= (k) && (k) < hi)
#define SEAM(k) do { if (IN(k) && IN((k) + 1)) xcd_barrier(bar); } while (0)
    if (lo < 0) grid.sync();
    if (threadIdx.x < 16) ((LAS unsigned*)(L + MISC_OFF))[threadIdx.x] = 0u;
    __syncthreads();
    XcdBarrier bar = xcd_barrier_post((unsigned*)(ws + WS_BAR), (volatile LAS unsigned*)(L + MISC_OFF));
    if (IN(0)) p0_prologue(p, L);
    SEAM(0);
    if (IN(1)) { pg8::Gemm g{(const bf16_t*)((const unsigned char*)p.out + OUT_XN), (const bf16_t*)(ws + WS_WTA), SEQ, 4096, 1024, 1024, 0, 0};
        pg8::StaticOrder S; S.init(SEQ, 4096, G, (int)blockIdx.x);
        pg8::EpiQKV E{(bf16_t*)(ws + WS_R1), (bf16_t*)(ws + WS_R2)};
        pg8::gemm_phase<pg8::EpiQKV, pg8::StaticOrder>(L, g, S, E); }
    SEAM(1);
    if (IN(2)) x_phase<false>(p, L, (int)blockIdx.x, (G == 256 ? (NCH - 1) * 8 : NCH * 8), G);
    SEAM(2);
    if (IN(3)) {
        if (G == 256) { const int b = blockIdx.x, x = b & 7, y = b >> 3, qid = x + 8 * (y >> 2), sl = y & 3; const bool ml = qid < 4 * NSEG_M;
            const int qq = ml ? qid : qid - 4 * NSEG_M, ns = ml ? NSEG_M : NSEG_G, hh = qq / ns, gg = qq - hh * ns;
            if (gg == ns - 1 && sl == 0) { const int it = (NCH - 1) * 8 + (ml ? 0 : 4) + hh; x_phase<true>(p, L, it, it + 1, 256); }
            if (gg == ns - 1 && sl != 0) {
                const int wv = __builtin_amdgcn_readfirstlane(threadIdx.x >> 6), wi = (((ml ? 0 : 4) + hh) * 3 + (sl - 1)) * 8 + wv;
                LAS float* scr = (LAS float*)(L + wv * 8448);
                for (int it = TR_DEF1_LO + wi; it < TR_DEF1_HI; it += 192) transpose_global_item(p, it, scr, (int)(threadIdx.x & 63)); } }
        scan_phase(p, L, false);
    }
    SEAM(3);
    if (IN(4)) scan_phase(p, L, true);
    SEAM(4);
    if (IN(5)) { pg8::Gemm g{(const bf16_t*)((const unsigned char*)p.out + OUT_XN), (const bf16_t*)(ws + WS_WTB), SEQ, 4096, 1024, 1024, 0, 0};
        pg8::StaticOrder S; S.init(SEQ, 4096, G, (int)blockIdx.x);
        pg8::EpiGate E{(bf16_t*)(ws + WS_R1), (bf16_t*)(ws + WS_R2), (const float*)(ws + WS_HSS), p.in[9], p.in[10]};
        pg8::gemm_phase<pg8::EpiGate, pg8::StaticOrder>(L, g, S, E); }
    SEAM(5);
    if (IN(6)) { pg8::Gemm g{(const bf16_t*)(ws + WS_R1), (const bf16_t*)(ws + WS_WTBM), SEQ, 1024, 1024, 2048, (size_t)1024 * 2, (size_t)2 * MiB};
        pg8::TwoPassOrder S; S.init(SEQ, 1024, G, (int)blockIdx.x);
        pg8::EpiMerge E{(bf16_t*)(ws + WS_AQ), (const bf16_t*)(ws + WS_R2)};
        pg8::gemm_phase<pg8::EpiMerge, pg8::TwoPassOrder>(L, g, S, E); }
    SEAM(6);
    if (IN(7)) { pg8::Gemm g{(const bf16_t*)(ws + WS_AQ), (const bf16_t*)(ws + WS_WTO), SEQ, 1024, 1024, 1024, 0, 0};
        pg8::StaticOrder S; S.init(SEQ, 1024, G, (int)blockIdx.x);
        pg8::EpiResid E{p.in[0], (bf16_t*)(ws + WS_KU), (float*)(ws + WS_SS1)};
        pg8::gemm_phase<pg8::EpiResid, pg8::StaticOrder>(L, g, S, E); }
    SEAM(7);
    if (IN(8)) { pg8::Gemm g{(const bf16_t*)(ws + WS_KU), (const bf16_t*)(ws + WS_WTFF), SEQ, 2 * DFF, 1024, 1024, 0, 0};
        pg8::StaticOrder S; S.init(SEQ, 2 * DFF, G, (int)blockIdx.x);
        pg8::EpiFF E{(bf16_t*)(ws + WS_FF), (const float*)(ws + WS_SS1)};
        pg8::gemm_phase<pg8::EpiFF, pg8::StaticOrder>(L, g, S, E);
        if (G == 256 && blockIdx.x >= 128) {
            const int wv = __builtin_amdgcn_readfirstlane(threadIdx.x >> 6), wi = ((int)blockIdx.x - 128) * 8 + wv;
            LAS float* scr = (LAS float*)(L + wv * 8448);
            for (int it = TR_DEF2_LO + wi; it < TR_NITEMS; it += 1024) transpose_global_item(p, it, scr, (int)(threadIdx.x & 63)); } }
    SEAM(8);
    if (IN(9)) { pg8::Gemm g{(const bf16_t*)(ws + WS_FF), (const bf16_t*)(ws + WS_WTD), SEQ, 1024, DFF, DFF, 0, 0};
        pg8::StaticOrder S; S.init(SEQ, 1024, G, (int)blockIdx.x);
        pg8::EpiFinal E{p.out, (const bf16_t*)(ws + WS_KU), p.in[18], (float*)(ws + WS_SS2), (unsigned*)(ws + WS_PCNT)};
        pg8::gemm_phase<pg8::EpiFinal, pg8::StaticOrder>(L, g, S, E); }
#undef IN
#undef SEAM
}

extern "C" void kernel_launch(void* const* d_in, const int* in_sizes, int n_in, void* d_out, int out_size, void* d_ws, size_t ws_size, hipStream_t stream) {
    static int grid = 0;
    if (grid == 0) {
        if (n_in != 19 || out_size != SEQ * DM || ws_size < WS_END) { fprintf(stderr, "kernel_launch: unexpected sizes (n_in %d out %d ws %zu)\n", n_in, out_size, ws_size); grid = -1; return; }
        int dev = 0, cus = 0, per_cu = 0;
        (void)hipGetDevice(&dev); (void)hipDeviceGetAttribute(&cus, hipDeviceAttributeMultiprocessorCount, dev);
        if (hipFuncSetAttribute((const void*)fwd_megakernel, hipFuncAttributeMaxDynamicSharedMemorySize, LDS_BYTES) != hipSuccess) { fprintf(stderr, "kernel_launch: hipFuncSetAttribute failed\n"); grid = -1; return; }
        if (hipOccupancyMaxActiveBlocksPerMultiprocessor(&per_cu, (const void*)fwd_megakernel, 512, LDS_BYTES) != hipSuccess || per_cu < 1) { fprintf(stderr, "kernel_launch: occupancy query says %d\n", per_cu); per_cu = 1; }
        (void)hipGetLastError();
        grid = cus * 1;
        if (grid <= 0) grid = 256;
    }
    if (grid < 0) return;
    if (hipMemsetAsync(d_ws, 0, CTL_ZERO_BYTES, stream) != hipSuccess) { fprintf(stderr, "kernel_launch: memset failed\n"); return; }
    Params a{};
    for (int i = 0; i < 19; ++i) a.in[i] = (const float*)d_in[i];
    a.out = (float*)d_out; a.ws = (unsigned char*)d_ws;
#if N_LAUNCH_MODE == 1
    a.ph_lo = 0; a.ph_hi = 10;
    void* args[] = {&a};
    hipError_t e = hipLaunchCooperativeKernel((const void*)fwd_megakernel, dim3(grid), dim3(512), args, LDS_BYTES, stream);
    if (e != hipSuccess) fprintf(stderr, "cooperative launch failed: %s (grid %d)\n", hipGetErrorString(e), grid);
#else
    for (int ph = 0; ph < 10; ++ph) { a.ph_lo = ph; a.ph_hi = ph + 1;
        hipLaunchKernelGGL(fwd_megakernel, dim3(grid), dim3(512), LDS_BYTES, stream, a); }
#endif
}
```

```cpp
#include <hip/hip_runtime.h>
#include <hip/hip_cooperative_groups.h>
#include <cstdio>
#include <cstdint>
namespace cg = cooperative_groups;

#define LAS __attribute__((address_space(3)))
typedef unsigned short bf16_t;
typedef short bf16x8 __attribute__((ext_vector_type(8)));
typedef float f32x4 __attribute__((ext_vector_type(4)));
typedef unsigned u32x4 __attribute__((ext_vector_type(4)));
typedef unsigned u32x2 __attribute__((ext_vector_type(2)));

#ifndef N_LAUNCH_MODE
#define N_LAUNCH_MODE 1
#endif

constexpr int DM = 1024, SEQ = 16384, TP = SEQ + 64, NCH = 257, NPROJ = 8216, DFF = 2816;
constexpr float EPS = 1e-6f;
constexpr float QSCALE = 0.08838834764831845f;
constexpr int NSEG_M = 9, NSEG_G = 7;
__host__ __device__ constexpr int seg_start_b(bool ml, int g) { return ml ? (g * 257 + 4) / 9 : (g * 257 + 3) / 7; }

constexpr size_t MiB = 1u << 20;
constexpr size_t WS_SS1 = 0, WS_SS2 = 65536, WS_BAR = 131072, WS_PCNT = 147456, CTL_ZERO_BYTES = 163840;
constexpr size_t WS_GI = 1 * MiB, WS_GF = 1 * MiB + 512 * 1024, WS_GA = 2 * MiB;
constexpr size_t WS_HSS = 4 * MiB;
constexpr size_t WS_CHB = 8 * MiB, WS_CHM = 8 * MiB + 512 * 1024, WS_CHG = 9 * MiB, WS_BT = 9 * MiB + 65536, WS_SEGBT = 9 * MiB + 768 * 1024;
constexpr size_t WS_WTA = 10 * MiB, WS_WTB = 18 * MiB, WS_WTBM = 26 * MiB, WS_WTO = 30 * MiB, WS_WTFF = 32 * MiB, WS_WTD = 43 * MiB;
constexpr size_t WS_R1 = 49 * MiB;
constexpr size_t WS_R2 = 114 * MiB;
constexpr size_t WS_AQ = 179 * MiB;
constexpr size_t WS_KU = 212 * MiB;
constexpr size_t WS_SEG = 245 * MiB;
constexpr size_t WS_FF = WS_R1;
constexpr size_t WS_END = 256 * MiB;
constexpr size_t OUT_XN = 0, OUT_WW = 32 * MiB;

constexpr int LDS_BYTES = 147456, MISC_OFF = 146432;

typedef float f32x2_t __attribute__((ext_vector_type(2)));
typedef __bf16 bf16x2_t __attribute__((ext_vector_type(2)));
__device__ __forceinline__ unsigned cvt_pk_bf16(float lo, float hi) { const f32x2_t v = {lo, hi}; const bf16x2_t b = __builtin_convertvector(v, bf16x2_t); return __builtin_bit_cast(unsigned, b); }
__device__ __forceinline__ float bf_lo(unsigned u) { return __uint_as_float(u << 16); }
__device__ __forceinline__ float bf_hi(unsigned u) { return __uint_as_float(u & 0xffff0000u); }
__device__ __forceinline__ float bf2f(bf16_t b) { return __uint_as_float(((unsigned)b) << 16); }
__device__ __forceinline__ bf16_t f2bf(float f) { return (bf16_t)(cvt_pk_bf16(f, 0.f) & 0xffffu); }
#define DPP_F(old, src, ctrl, rmask, bc) __int_as_float(__builtin_amdgcn_update_dpp(__float_as_int(old), __float_as_int(src), (ctrl), (rmask), 0xf, (bc)))
__device__ __forceinline__ float wave_sum(float v) {
    v += DPP_F(0.f, v, 0xB1, 0xf, true);
    v += DPP_F(0.f, v, 0x4E, 0xf, true);
    v += DPP_F(0.f, v, 0x141, 0xf, true);
    v += DPP_F(0.f, v, 0x140, 0xf, true);
    v += DPP_F(0.f, v, 0x142, 0xa, false);
    v += DPP_F(0.f, v, 0x143, 0xc, false);
    return __int_as_float(__builtin_amdgcn_readlane(__float_as_int(v), 63));
}
__device__ __forceinline__ float wave_max(float v) {
    v = fmaxf(v, DPP_F(v, v, 0xB1, 0xf, false));
    v = fmaxf(v, DPP_F(v, v, 0x4E, 0xf, false));
    v = fmaxf(v, DPP_F(v, v, 0x141, 0xf, false));
    v = fmaxf(v, DPP_F(v, v, 0x140, 0xf, false));
    v = fmaxf(v, DPP_F(v, v, 0x142, 0xa, false));
    v = fmaxf(v, DPP_F(v, v, 0x143, 0xc, false));
    return __int_as_float(__builtin_amdgcn_readlane(__float_as_int(v), 63));
}
__device__ __forceinline__ float wave_scan_sum(float v) {
    v += DPP_F(0.f, v, 0x111, 0xf, true); v += DPP_F(0.f, v, 0x112, 0xf, true); v += DPP_F(0.f, v, 0x114, 0xf, true); v += DPP_F(0.f, v, 0x118, 0xf, true);
    v += DPP_F(0.f, v, 0x142, 0xa, false); v += DPP_F(0.f, v, 0x143, 0xc, false);
    return v;
}
__device__ __forceinline__ float wave_scan_max(float v) {
    v = fmaxf(v, DPP_F(v, v, 0x111, 0xf, false)); v = fmaxf(v, DPP_F(v, v, 0x112, 0xf, false)); v = fmaxf(v, DPP_F(v, v, 0x114, 0xf, false)); v = fmaxf(v, DPP_F(v, v, 0x118, 0xf, false));
    v = fmaxf(v, DPP_F(v, v, 0x142, 0xa, false)); v = fmaxf(v, DPP_F(v, v, 0x143, 0xc, false));
    return v;
}
__device__ __forceinline__ float sigmoidf_(float x) { return __builtin_amdgcn_rcpf(1.f + __expf(-x)); }
__device__ __forceinline__ float siluf_(float x) { return x * __builtin_amdgcn_rcpf(1.f + __expf(-x)); }
__device__ __forceinline__ float logsigmoidf_(float z) { return fminf(z, 0.f) - __logf(1.f + __expf(-fabsf(z))); }
#define LDS_BARRIER() do { asm volatile("s_waitcnt lgkmcnt(0)" ::: "memory"); __builtin_amdgcn_s_barrier(); asm volatile("" ::: "memory"); } while (0)
#define MFMA16(a, b, c) __builtin_amdgcn_mfma_f32_16x16x32_bf16((a), (b), (c), 0, 0, 0)

namespace pg8 {
constexpr int BM = 256, BK = 64, HALF = 128, HTB = HALF * BK * 2, NXCD = 8, WGM = 1;
__host__ __device__ __forceinline__ int lds_byte(int r, int c) { const int st = (r >> 4) * 2 + (c >> 5), rr = r & 15, cc = c & 31, ob = rr * 64 + cc * 2; return st * 1024 + (ob ^ (((ob >> 9) & 1) << 5)); }
__host__ __device__ __forceinline__ void stage_rc(int b, int& R, int& C) { const int st = b / 1024, sb = b % 1024, swz = sb ^ (((sb >> 9) & 1) << 5); R = (st >> 1) * 16 + swz / 64; C = (st & 1) * 32 + (swz % 64) / 2; }
__host__ __device__ __forceinline__ int perm32(int rho) { const int n = rho >> 4, i = rho & 15; return 8 * (i >> 2) + 4 * n + (i & 3); }

struct Unit { int pm, pn, ks; };
struct Gemm { const bf16_t* A; const bf16_t* Bt; int M, N, K, lda; size_t ksA, ksB; };

struct StaticOrder {
    int nM, nN, nwg, G, c;
    __device__ void init(int M, int N, int G_, int c_) { nM = M / BM; nN = N / BM; nwg = nM * nN; G = G_; c = c_; }
    __device__ bool next(int i, Unit& u) const {
        const long Lx = (long)i * G + c; if (Lx >= nwg) return false;
        int wgid = (int)Lx; { const int q = nwg / NXCD, r = nwg % NXCD, xcd = wgid % NXCD, off = wgid / NXCD; wgid = (xcd < r ? xcd * (q + 1) : r * (q + 1) + (xcd - r) * q) + off; }
        const int nig = WGM * nN, gid = wgid / nig, fm = gid * WGM, gsz = (nM - fm) < WGM ? (nM - fm) : WGM;
        u.pm = fm + ((wgid % nig) % gsz); u.pn = (wgid % nig) / gsz; u.ks = 0; return true;
    }
};
struct TwoPassOrder {
    int ntile, nN, G, c;
    __device__ void init(int M, int N, int G_, int c_) { nN = N / BM; ntile = (M / BM) * nN; G = G_; c = c_; }
    __device__ bool next(int i, Unit& u) const {
        const int cc = (G % 8 == 0) ? (c % 8) * (G / 8) + c / 8 : c;
        const int tl = (i >> 1) * G + cc; if (tl >= ntile) return false;
        u.pm = tl / nN; u.pn = tl % nN; u.ks = i & 1; return true;
    }
};

template <class Epi, class Sched>
__device__ __forceinline__ void gemm_phase(LAS unsigned char* lds, const Gemm g, const Sched& S, const Epi& E) {
    const int tid = threadIdx.x, wid = __builtin_amdgcn_readfirstlane(tid >> 6), lane = tid & 63, wr = wid >> 2, wc = wid & 3, fr = lane & 15, fq = lane >> 4;
    const int K = g.K, nt = K / BK;
    unsigned voffA[2], voffB[2];
#pragma unroll
    for (int i = 0; i < 2; ++i) { int R, C; stage_rc(tid * 16 + i * 8192, R, C); const int Rb = (R & ~31) + perm32(R & 31);
        voffA[i] = (unsigned)(R * g.lda + C) * 2u; voffB[i] = (unsigned)(Rb * K + C) * 2u; }
    const size_t kstep = (size_t)(BK * 2);
    const size_t hstepA = (size_t)HALF * g.lda * 2, hstepB = (size_t)HALF * K * 2;
    const size_t tstepA = 2 * hstepA, tstepB = 2 * hstepB;
    const unsigned ldsw = (unsigned)wid * 1024u;
    const int aoff = lds_byte(wr * 64 + fr, fq * 8), boff = lds_byte(wc * 32 + fr, fq * 8);
#define PG8_SA(b, h) (((b) * 2 + (h)) * HTB)
#define PG8_SB(b, h) ((4 + (b) * 2 + (h)) * HTB)
#define PG8_STAGE(bufoff, gbase, voff) do { _Pragma("unroll") for (int _i = 0; _i < 2; ++_i) \
        __builtin_amdgcn_global_load_lds((const unsigned*)((const char*)(gbase) + (voff)[_i]), (LAS unsigned*)(lds + (bufoff) + ldsw + _i * 8192), 16, 0, 0); } while (0)
#define PG8_LDA(dst, b, h) do { _Pragma("unroll") for (int m = 0; m < 4; ++m) _Pragma("unroll") for (int k = 0; k < 2; ++k) dst[m][k] = *(const LAS bf16x8*)(lds + PG8_SA(b, h) + aoff + m * 2048 + k * 1024); } while (0)
#define PG8_LDB(dst, b, h) do { _Pragma("unroll") for (int n = 0; n < 2; ++n) _Pragma("unroll") for (int k = 0; k < 2; ++k) dst[n][k] = *(const LAS bf16x8*)(lds + PG8_SB(b, h) + boff + n * 2048 + k * 1024); } while (0)
#define PG8_MMA(ai, bj, At, Bt) do { __builtin_amdgcn_s_setprio(1); _Pragma("unroll") for (int m = 0; m < 4; ++m) _Pragma("unroll") for (int n = 0; n < 2; ++n) _Pragma("unroll") for (int k = 0; k < 2; ++k) \
        acc[ai][bj][m][n] = __builtin_amdgcn_mfma_f32_16x16x32_bf16(Bt[n][k], At[m][k], acc[ai][bj][m][n], 0, 0, 0); __builtin_amdgcn_s_setprio(0); } while (0)
#define PG8_WAIT_V(n) asm volatile("s_waitcnt vmcnt(" #n ")" ::: "memory")
#define PG8_WAIT_L(n) asm volatile("s_waitcnt lgkmcnt(" #n ")" ::: "memory")
#define PG8_BAR __builtin_amdgcn_s_barrier()
#define PG8_SCHED __builtin_amdgcn_sched_barrier(0)
    Unit cur, nxt; int ui = 0;
    if (!S.next(0, cur)) return;
    f32x4 acc[2][2][4][2];
#pragma unroll
    for (int a = 0; a < 2; ++a)
#pragma unroll
        for (int b = 0; b < 2; ++b)
#pragma unroll
            for (int m = 0; m < 4; ++m)
#pragma unroll
                for (int n = 0; n < 2; ++n) acc[a][b][m][n] = (f32x4){0.f, 0.f, 0.f, 0.f};
    bf16x8 At[4][2], B0[2][2], B1[2][2];
    const char* cA = (const char*)g.A + (size_t)cur.pm * tstepA + (size_t)cur.ks * g.ksA; const char* cB = (const char*)g.Bt + (size_t)cur.pn * tstepB + (size_t)cur.ks * g.ksB;
    PG8_STAGE(PG8_SB(0, 0), cB, voffB); PG8_STAGE(PG8_SB(0, 1), cB + hstepB, voffB); PG8_STAGE(PG8_SA(0, 0), cA, voffA); PG8_STAGE(PG8_SA(0, 1), cA + hstepA, voffA);
    if (wr == 1) PG8_BAR;
    PG8_WAIT_V(2); PG8_BAR;
    PG8_STAGE(PG8_SB(1, 0), cB + kstep, voffB); PG8_STAGE(PG8_SA(1, 0), cA + kstep, voffA); PG8_STAGE(PG8_SB(1, 1), cB + hstepB + kstep, voffB);
    PG8_WAIT_V(6); PG8_BAR;
    for (;;) {
        const bool has_next = S.next(ui + 1, nxt);
        const char* nA = has_next ? (const char*)g.A + (size_t)nxt.pm * tstepA + (size_t)nxt.ks * g.ksA : cA; const char* nB = has_next ? (const char*)g.Bt + (size_t)nxt.pn * tstepB + (size_t)nxt.ks * g.ksB : cB;
        for (int t = 0; t < nt; t += 2) {
            const bool last = (t == nt - 2);
            const char* a1 = cA + (size_t)(t + 1) * kstep;
            const char* a2 = last ? nA : cA + (size_t)(t + 2) * kstep; const char* b2 = last ? nB : cB + (size_t)(t + 2) * kstep;
            const char* a3 = a2 + kstep; const char* b3 = b2 + kstep;
            PG8_LDB(B0, 0, 0); PG8_LDB(B1, 0, 1); PG8_SCHED; PG8_LDA(At, 0, 0); PG8_STAGE(PG8_SA(1, 1), a1 + hstepA, voffA);
            PG8_WAIT_V(8); PG8_WAIT_L(0); PG8_BAR; PG8_MMA(0, 0, At, B0); PG8_MMA(0, 1, At, B1); PG8_BAR; PG8_SCHED;
            PG8_LDA(At, 0, 1); PG8_STAGE(PG8_SB(0, 0), b2, voffB); PG8_STAGE(PG8_SB(0, 1), b2 + hstepB, voffB); PG8_STAGE(PG8_SA(0, 0), a2, voffA);
            PG8_WAIT_V(8); PG8_WAIT_L(0); PG8_BAR; PG8_MMA(1, 0, At, B0); PG8_MMA(1, 1, At, B1); PG8_BAR; PG8_SCHED;
            PG8_LDB(B0, 1, 0); PG8_LDB(B1, 1, 1); PG8_SCHED; PG8_LDA(At, 1, 0); PG8_STAGE(PG8_SA(0, 1), a2 + hstepA, voffA);
            PG8_WAIT_V(8); PG8_WAIT_L(0); PG8_BAR; PG8_MMA(0, 0, At, B0); PG8_MMA(0, 1, At, B1); PG8_BAR; PG8_SCHED;
            PG8_LDA(At, 1, 1); PG8_STAGE(PG8_SB(1, 0), b3, voffB); PG8_STAGE(PG8_SB(1, 1), b3 + hstepB, voffB); PG8_STAGE(PG8_SA(1, 0), a3, voffA);
            PG8_WAIT_V(8); PG8_WAIT_L(0); PG8_BAR; PG8_MMA(1, 0, At, B0); PG8_MMA(1, 1, At, B1); PG8_BAR; PG8_SCHED;
        }
        if (wr == 0) PG8_BAR;
        E(acc, cur, wr, wc, fr, fq);
        if (!has_next) break;
#pragma unroll
        for (int a = 0; a < 2; ++a)
#pragma unroll
            for (int b = 0; b < 2; ++b)
#pragma unroll
                for (int m = 0; m < 4; ++m)
#pragma unroll
                    for (int n = 0; n < 2; ++n) acc[a][b][m][n] = (f32x4){0.f, 0.f, 0.f, 0.f};
        cur = nxt; cA = nA; cB = nB; ++ui;
        if (wr == 1) PG8_BAR;
    }
    PG8_WAIT_V(0);
    PG8_BAR;
#undef PG8_SA
#undef PG8_SB
#undef PG8_STAGE
#undef PG8_LDA
#undef PG8_LDB
#undef PG8_MMA
#undef PG8_WAIT_V
#undef PG8_WAIT_L
#undef PG8_BAR
#undef PG8_SCHED
}

__device__ __forceinline__ u32x4 pack8(const f32x4 v0, const f32x4 v1) { u32x4 w; w.x = cvt_pk_bf16(v0[0], v0[1]); w.y = cvt_pk_bf16(v0[2], v0[3]); w.z = cvt_pk_bf16(v1[0], v1[1]); w.w = cvt_pk_bf16(v1[2], v1[3]); return w; }
__device__ __forceinline__ void unpack8(const u32x4 w, f32x4& v0, f32x4& v1) { v0 = (f32x4){bf_lo(w.x), bf_hi(w.x), bf_lo(w.y), bf_hi(w.y)}; v1 = (f32x4){bf_lo(w.z), bf_hi(w.z), bf_lo(w.w), bf_hi(w.w)}; }

struct EpiQKV {
    bf16_t* rawqk; bf16_t* vbuf;
    __device__ __forceinline__ void operator()(const f32x4 (&acc)[2][2][4][2], const Unit& u, int wr, int wc, int fr, int fq) const {
        int colt = u.pn * BM; bf16_t* base = rawqk; if (colt >= 2048) { base = vbuf; colt -= 2048; }
        const int row0 = 64 + u.pm * BM + wr * 64 + fr, col0 = colt + wc * 32 + 8 * fq;
#pragma unroll
        for (int ai = 0; ai < 2; ++ai)
#pragma unroll
            for (int m = 0; m < 4; ++m) { bf16_t* rowp = base + (size_t)(row0 + ai * HALF + m * 16) * 2048 + col0;
#pragma unroll
                for (int bj = 0; bj < 2; ++bj) *(u32x4*)(rowp + bj * HALF) = pack8(acc[ai][bj][m][0], acc[ai][bj][m][1]); }
    }
};

struct EpiGate {
    bf16_t* H; bf16_t* G2; const float* hss; const float* mg; const float* gg;
    __device__ __forceinline__ void operator()(const f32x4 (&acc)[2][2][4][2], const Unit& u, int wr, int wc, int fr, int fq) const {
        const int row0 = u.pm * BM + wr * 64 + fr;
        if (u.pn >= 8) {
            const int col0 = (u.pn - 8) * BM + wc * 32 + 8 * fq;
#pragma unroll
            for (int ai = 0; ai < 2; ++ai)
#pragma unroll
                for (int m = 0; m < 4; ++m) { bf16_t* rowp = G2 + (size_t)(row0 + ai * HALF + m * 16) * 2048 + col0;
#pragma unroll
                    for (int bj = 0; bj < 2; ++bj) { f32x4 v0 = acc[ai][bj][m][0], v1 = acc[ai][bj][m][1];
#pragma unroll
                        for (int e = 0; e < 4; ++e) { v0[e] = sigmoidf_(v0[e]); v1[e] = sigmoidf_(v1[e]); }
                        *(u32x4*)(rowp + bj * HALF) = pack8(v0, v1); } }
        } else {
            const int br = u.pn >> 2, head = u.pn & 3;
            const float* gain = (br ? gg : mg) + head * 256 + wc * 32 + 8 * fq;
            f32x4 gv[2][2];
#pragma unroll
            for (int bj = 0; bj < 2; ++bj) { gv[bj][0] = *(const f32x4*)(gain + bj * HALF); gv[bj][1] = *(const f32x4*)(gain + bj * HALF + 4); }
            const int col0 = br * 1024 + head * 256 + wc * 32 + 8 * fq;
#pragma unroll
            for (int ai = 0; ai < 2; ++ai) {
                float rs4[4];
                {   f32x4 sa[4], sb[4];
#pragma unroll
                    for (int m = 0; m < 4; ++m) { const int row = row0 + ai * HALF + m * 16;
                        sa[m] = *(const f32x4*)(hss + (size_t)row * 64 + br * 32 + head * 8); sb[m] = *(const f32x4*)(hss + (size_t)row * 64 + br * 32 + head * 8 + 4); }
#pragma unroll
                    for (int m = 0; m < 4; ++m) { const f32x4 s0 = sa[m], s1 = sb[m];
                        const float ssum = ((s0[0] + s0[1]) + (s0[2] + s0[3])) + ((s1[0] + s1[1]) + (s1[2] + s1[3]));
                        rs4[m] = __builtin_amdgcn_rsqf(ssum * (1.f / 256.f) + EPS); } }
                u32x4 hraw[4][2];
#pragma unroll
                for (int m = 0; m < 4; ++m)
#pragma unroll
                    for (int bj = 0; bj < 2; ++bj) hraw[m][bj] = *(const u32x4*)(H + (size_t)(row0 + ai * HALF + m * 16) * 2048 + col0 + bj * HALF);
#pragma unroll
                for (int m = 0; m < 4; ++m) { const int row = row0 + ai * HALF + m * 16;
                    const float rstd = rs4[m];
                    bf16_t* rowp = H + (size_t)row * 2048 + col0;
#pragma unroll
                    for (int bj = 0; bj < 2; ++bj) { f32x4 a0 = acc[ai][bj][m][0], a1 = acc[ai][bj][m][1], h0, h1;
                        unpack8(hraw[m][bj], h0, h1);
#pragma unroll
                        for (int e = 0; e < 4; ++e) { const float g0 = br ? siluf_(a0[e]) : sigmoidf_(a0[e]), g1 = br ? siluf_(a1[e]) : sigmoidf_(a1[e]);
                            h0[e] = h0[e] * rstd * gv[bj][0][e] * g0; h1[e] = h1[e] * rstd * gv[bj][1][e] * g1; }
                        *(u32x4*)(rowp + bj * HALF) = pack8(h0, h1); } } }
        }
    }
};

struct EpiMerge {
    bf16_t* MG; const bf16_t* G2;
    __device__ __forceinline__ void operator()(const f32x4 (&acc)[2][2][4][2], const Unit& u, int wr, int wc, int fr, int fq) const {
        const int row0 = u.pm * BM + wr * 64 + fr, col0 = u.pn * BM + wc * 32 + 8 * fq;
#pragma unroll
        for (int ai = 0; ai < 2; ++ai) {
            u32x4 gr[4][2], pr[4][2];
#pragma unroll
            for (int m = 0; m < 4; ++m)
#pragma unroll
                for (int bj = 0; bj < 2; ++bj) { const int row = row0 + ai * HALF + m * 16;
                    gr[m][bj] = *(const u32x4*)(G2 + (size_t)row * 2048 + u.ks * 1024 + col0 + bj * HALF);
                    pr[m][bj] = u.ks ? *(const u32x4*)(MG + (size_t)row * 1024 + col0 + bj * HALF) : (u32x4){0u, 0u, 0u, 0u}; }
#pragma unroll
            for (int m = 0; m < 4; ++m) { const int row = row0 + ai * HALF + m * 16; bf16_t* rowp = MG + (size_t)row * 1024 + col0;
#pragma unroll
                for (int bj = 0; bj < 2; ++bj) { f32x4 g0, g1, p0, p1; unpack8(gr[m][bj], g0, g1); unpack8(pr[m][bj], p0, p1);
                    *(u32x4*)(rowp + bj * HALF) = pack8(acc[ai][bj][m][0] * g0 + p0, acc[ai][bj][m][1] * g1 + p1); } } }
    }
};

struct EpiResid {
    const float* resid; bf16_t* h1b; float* sumsq;
    __device__ __forceinline__ void operator()(const f32x4 (&acc)[2][2][4][2], const Unit& u, int wr, int wc, int fr, int fq) const {
        const int row0 = u.pm * BM + wr * 64 + fr, col0 = u.pn * BM + wc * 32 + 8 * fq;
#pragma unroll
        for (int ai = 0; ai < 2; ++ai)
#pragma unroll
            for (int m = 0; m < 4; ++m) { const int row = row0 + ai * HALF + m * 16; float ss = 0.f;
#pragma unroll
                for (int bj = 0; bj < 2; ++bj) { const size_t o = (size_t)row * 1024 + col0 + bj * HALF;
                    const f32x4 v0 = *(const f32x4*)(resid + o) + acc[ai][bj][m][0], v1 = *(const f32x4*)(resid + o + 4) + acc[ai][bj][m][1];
                    ss += (v0[0] * v0[0] + v0[1] * v0[1]) + (v0[2] * v0[2] + v0[3] * v0[3]) + (v1[0] * v1[0] + v1[1] * v1[1]) + (v1[2] * v1[2] + v1[3] * v1[3]);
                    *(u32x4*)(h1b + o) = pack8(v0, v1); }
                ss += __shfl_xor(ss, 16); ss += __shfl_xor(ss, 32);
                if (fq == 0) __hip_atomic_fetch_add(sumsq + row, ss, __ATOMIC_RELAXED, __HIP_MEMORY_SCOPE_AGENT); }
    }
};

struct EpiFF {
    bf16_t* FF; const float* sumsq;
    __device__ __forceinline__ void operator()(const f32x4 (&acc)[2][2][4][2], const Unit& u, int wr, int wc, int fr, int fq) const {
        const int row0 = u.pm * BM + wr * 64 + fr, col0 = u.pn * HALF + wc * 32 + 8 * fq;
        float ssq[2][4];
#pragma unroll
        for (int ai = 0; ai < 2; ++ai)
#pragma unroll
            for (int m = 0; m < 4; ++m) ssq[ai][m] = sumsq[row0 + ai * HALF + m * 16];
#pragma unroll
        for (int ai = 0; ai < 2; ++ai)
#pragma unroll
            for (int m = 0; m < 4; ++m) { const int row = row0 + ai * HALF + m * 16;
                const float r = __builtin_amdgcn_rsqf(ssq[ai][m] * (1.f / 1024.f) + EPS);
                f32x4 v0, v1;
#pragma unroll
                for (int e = 0; e < 4; ++e) { v0[e] = siluf_(r * acc[ai][0][m][0][e]) * (r * acc[ai][1][m][0][e]); v1[e] = siluf_(r * acc[ai][0][m][1][e]) * (r * acc[ai][1][m][1][e]); }
                *(u32x4*)(FF + (size_t)row * DFF + col0) = pack8(v0, v1); }
    }
};

struct EpiFinal {
    float* out; const bf16_t* h1b; const float* fg; float* sumsq; unsigned* cnt;
    __device__ __forceinline__ void operator()(f32x4 (&acc)[2][2][4][2], const Unit& u, int wr, int wc, int fr, int fq) const {
        const int row0 = u.pm * BM + wr * 64 + fr, col0 = u.pn * BM + wc * 32 + 8 * fq;
#pragma unroll
        for (int ai = 0; ai < 2; ++ai)
#pragma unroll
            for (int m = 0; m < 4; ++m) { const int row = row0 + ai * HALF + m * 16; float ss = 0.f;
#pragma unroll
                for (int bj = 0; bj < 2; ++bj) { const size_t o = (size_t)row * 1024 + col0 + bj * HALF;
                    f32x4 r0, r1; unpack8(*(const u32x4*)(h1b + o), r0, r1);
                    const f32x4 v0 = r0 + acc[ai][bj][m][0], v1 = r1 + acc[ai][bj][m][1];
                    acc[ai][bj][m][0] = v0; acc[ai][bj][m][1] = v1;
                    ss += (v0[0] * v0[0] + v0[1] * v0[1]) + (v0[2] * v0[2] + v0[3] * v0[3]) + (v1[0] * v1[0] + v1[1] * v1[1]) + (v1[2] * v1[2] + v1[3] * v1[3]); }
                ss += __shfl_xor(ss, 16); ss += __shfl_xor(ss, 32);
                if (fq == 0) __hip_atomic_fetch_add(sumsq + row, ss, __ATOMIC_RELAXED, __HIP_MEMORY_SCOPE_AGENT); }
        asm volatile("s_waitcnt vmcnt(0)" ::: "memory");
        __syncthreads();
        if (threadIdx.x == 0) {
            __threadfence();
            unsigned* c = cnt + u.pm * 64;
            __hip_atomic_fetch_add(c, 1u, __ATOMIC_RELAXED, __HIP_MEMORY_SCOPE_AGENT);
            unsigned sp = 0;
            while (__hip_atomic_load(c, __ATOMIC_RELAXED, __HIP_MEMORY_SCOPE_AGENT) < 4u) { __builtin_amdgcn_s_sleep(1); if (++sp > (1u << 22)) break; }
            __threadfence();
        }
        __syncthreads();
        f32x4 gv[2][2];
#pragma unroll
        for (int bj = 0; bj < 2; ++bj) { gv[bj][0] = *(const f32x4*)(fg + col0 + bj * HALF); gv[bj][1] = *(const f32x4*)(fg + col0 + bj * HALF + 4); }
#pragma unroll
        for (int ai = 0; ai < 2; ++ai)
#pragma unroll
            for (int m = 0; m < 4; ++m) { const int row = row0 + ai * HALF + m * 16;
                const float ssum = __hip_atomic_load(sumsq + row, __ATOMIC_RELAXED, __HIP_MEMORY_SCOPE_AGENT);
                const float rs = __builtin_amdgcn_rsqf(ssum * (1.f / 1024.f) + EPS);
#pragma unroll
                for (int bj = 0; bj < 2; ++bj) { const size_t o = (size_t)row * 1024 + col0 + bj * HALF;
                    *(f32x4*)(out + o) = acc[ai][bj][m][0] * rs * gv[bj][0]; *(f32x4*)(out + o + 4) = acc[ai][bj][m][1] * rs * gv[bj][1]; } }
    }
};
}


#define XB_TMO      128
#define XB_XCNT(j)  (256  + 64 * (j))
#define XB_XSUB(j)  (1280 + 64 * (j))
#define XB_XGEN(j)  (2304 + 64 * (j))
#define XB_TOP      3328
#define XB_TOPGEN   3392
#define XCD_BAR_WORDS 3456
#define XB_SPIN_CAP (1u << 18)
__device__ __forceinline__ unsigned xb_ld(unsigned* p)              { return __hip_atomic_load(p, __ATOMIC_RELAXED, __HIP_MEMORY_SCOPE_AGENT); }
__device__ __forceinline__ unsigned xb_add(unsigned* p, unsigned v) { return __hip_atomic_fetch_add(p, v, __ATOMIC_RELAXED, __HIP_MEMORY_SCOPE_AGENT); }
__device__ __forceinline__ unsigned xb_xcc_id() { return (unsigned)__builtin_amdgcn_s_getreg((3 << 11) | 20) & 0xFu; }
#define XB_SPIN(cond, bar) do { unsigned _sp = 0; while (cond) { __builtin_amdgcn_s_sleep(1); \
    if ((++_sp & 255u) == 0u) { if (xb_ld(&(bar)[XB_TMO])) break; if (_sp > XB_SPIN_CAP) { atomicAdd(&(bar)[XB_TMO], 1u); break; } } } } while (0)
struct XcdBarrier { unsigned* bar; unsigned x; volatile LAS unsigned* st; };
__device__ __forceinline__ XcdBarrier xcd_barrier_post(unsigned* bar, volatile LAS unsigned* st) {
    XcdBarrier b; b.bar = bar; b.x = xb_xcc_id(); b.st = st;
    if (threadIdx.x == 0) (void)xb_add(&bar[XB_XCNT(b.x)], 1u);
    return b;
}
__device__ __forceinline__ void xcd_barrier_complete(unsigned* bar, unsigned x, unsigned& nloc, unsigned& nx) {
    const unsigned G = gridDim.x * gridDim.y * gridDim.z;
    unsigned sum, cnt, mine, sp = 0u;
    for (;;) {
        sum = 0u; cnt = 0u; mine = 0u;
#pragma unroll
        for (unsigned j = 0; j < 16; ++j) { const unsigned c = xb_ld(&bar[XB_XCNT(j)]); sum += c; cnt += (c > 0u) ? 1u : 0u; mine = (j == x) ? c : mine; }
        if (sum == G) break;
        __builtin_amdgcn_s_sleep(1);
        if ((++sp & 255u) == 0u) { if (xb_ld(&bar[XB_TMO])) break; if (sp > XB_SPIN_CAP) { atomicAdd(&bar[XB_TMO], 1u); break; } }
    }
    nloc = mine > 0u ? mine : 1u; nx = cnt > 0u ? cnt : 1u;
}
__device__ __forceinline__ void xcd_barrier(const XcdBarrier& b) {
    asm volatile("s_waitcnt vmcnt(0)" ::: "memory");
    __syncthreads();
    if (threadIdx.x == 0) {
        unsigned* bar = b.bar;
        __builtin_amdgcn_s_waitcnt(0);
        unsigned nloc = b.st[0], nx = b.st[1];
        if (nloc == 0u) { xcd_barrier_complete(bar, b.x, nloc, nx); b.st[0] = nloc; b.st[1] = nx; }
        const unsigned old = xb_add(&bar[XB_XSUB(b.x)], 1u);
        const unsigned gen = old / nloc;
        if (old + 1u == (gen + 1u) * nloc) {
            __builtin_amdgcn_fence(__ATOMIC_RELEASE, "agent");
            asm volatile("s_waitcnt vmcnt(0)" ::: "memory");
            const unsigned og = xb_add(&bar[XB_TOP], 1u);
            const unsigned tg = og / nx;
            if (og + 1u == (tg + 1u) * nx) xb_add(&bar[XB_TOPGEN], 1u);
            else XB_SPIN(xb_ld(&bar[XB_TOPGEN]) == tg, bar);
            __builtin_amdgcn_fence(__ATOMIC_ACQUIRE, "agent");
            xb_add(&bar[XB_XGEN(b.x)], 1u);
            asm volatile("s_waitcnt vmcnt(0)" ::: "memory");
        } else {
            XB_SPIN(xb_ld(&bar[XB_XGEN(b.x)]) == gen, bar);
            __builtin_amdgcn_fence(__ATOMIC_ACQUIRE, "agent");
            asm volatile("s_waitcnt vmcnt(0)" ::: "memory");
        }
    }
    __syncthreads();
}

struct Params { const float* in[19]; float* out; unsigned char* ws; int ph_lo, ph_hi; };

__device__ __forceinline__ void transpose_item(const float* W, int ldw, int K, bf16_t* WT, int kb, int nb, LAS float* scr, int lane, const float* ksc) {
    const int k0 = 64 * kb, n0 = 32 * nb;
    const float* Wl = W + (size_t)(k0 + (lane >> 5)) * ldw + n0 + (lane & 31);
#pragma unroll
    for (int hh = 0; hh < 2; ++hh) { float tv[16];
#pragma unroll
        for (int i = 0; i < 16; ++i) tv[i] = Wl[(size_t)(2 * (16 * hh + i)) * ldw];
        if (ksc) {
#pragma unroll
            for (int i = 0; i < 16; ++i) tv[i] *= ksc[k0 + 2 * (16 * hh + i) + (lane >> 5)]; }
#pragma unroll
        for (int i = 0; i < 16; ++i) { const int kk = 2 * (16 * hh + i) + (lane >> 5); scr[kk * 33 + (lane & 31)] = tv[i]; } }
    asm volatile("s_waitcnt lgkmcnt(0)" ::: "memory");
    const int c = lane & 7;
#pragma unroll
    for (int j = 0; j < 4; ++j) { const int n = (lane >> 3) + 8 * j; const LAS float* s = scr + (8 * c) * 33 + n;
        u32x4 o; o.x = cvt_pk_bf16(s[0 * 33], s[1 * 33]); o.y = cvt_pk_bf16(s[2 * 33], s[3 * 33]); o.z = cvt_pk_bf16(s[4 * 33], s[5 * 33]); o.w = cvt_pk_bf16(s[6 * 33], s[7 * 33]);
        *(u32x4*)(WT + (size_t)(n0 + n) * K + k0 + 8 * c) = o; }
    asm volatile("s_waitcnt lgkmcnt(0)" ::: "memory");
}

__device__ __forceinline__ void p0_prologue(const Params& p, LAS unsigned char* L) {
    const int tid = threadIdx.x, lane = tid & 63, wave = __builtin_amdgcn_readfirstlane(tid >> 6);
    const int G = gridDim.x, gw = blockIdx.x * 8 + wave, NGW = G * 8;
    unsigned char* ws = p.ws;
    const float* w_in = p.in[3];
    {
        LAS float* scr = (LAS float*)(L + wave * 8448);
        constexpr int NITEMS = 3072 + 1024 + 1536 + 2816 + 1408;
        for (int it = gw; it < NITEMS; it += NGW) {
            int r = it; const float* src; int ldw, K = 1024, kb, nb; bf16_t* dst; const float* ksc = nullptr;
            if (r < 3072) { const int pc = r >> 9; r &= 511; kb = r >> 5; nb = r & 31; ldw = NPROJ;
                const int so = pc == 0 ? 0 : pc == 1 ? 3080 : pc == 2 ? 1024 : pc == 3 ? 4104 : pc == 4 ? 2056 : 5144;
                src = w_in + so; dst = (bf16_t*)(ws + (pc < 4 ? WS_WTA : WS_WTB)) + (size_t)(pc < 4 ? pc : pc - 4) * 1048576; }
            else if ((r -= 3072) < 1024) { kb = r >> 6; nb = r & 63; ldw = NPROJ; src = w_in + 6168; dst = (bf16_t*)(ws + WS_WTB) + (size_t)2 * 1048576; }
            else if ((r -= 1024) < 1536) { const int pc = r >> 9; r &= 511; kb = r >> 5; nb = r & 31; ldw = 1024; src = p.in[11 + pc]; dst = (bf16_t*)(ws + WS_WTBM) + (size_t)pc * 1048576; }
            else if ((r -= 1536) < 2816) { const int q = r >> 6; r &= 63; kb = r >> 2; nb = r & 3; const int i = q >> 1, isup = q & 1; ldw = DFF;
                src = p.in[15 + isup] + 128 * i; dst = (bf16_t*)(ws + WS_WTFF) + (size_t)(256 * i + 128 * isup) * 1024; ksc = p.in[14]; }
            else { r -= 2816; kb = r >> 5; nb = r & 31; ldw = 1024; K = DFF; src = p.in[17]; dst = (bf16_t*)(ws + WS_WTD); }
            transpose_item(src, ldw, K, dst, kb, nb, scr, lane, ksc);
        }
    }
    __syncthreads();
    {
        LAS float* xT = (LAS float*)L;
        LAS float* red = (LAS float*)(L + 65536);
#pragma unroll
        for (int rr = 0; rr < 2; ++rr) { const int row = 2 * wave + rr; const f32x4* xr = (const f32x4*)(p.in[1] + (size_t)row * 1024) + lane; const f32x4* gr = (const f32x4*)p.in[2] + lane;
            f32x4 v[4]; float s = 0.f;
#pragma unroll
            for (int j = 0; j < 4; ++j) { v[j] = xr[64 * j]; s += (v[j][0] * v[j][0] + v[j][1] * v[j][1]) + (v[j][2] * v[j][2] + v[j][3] * v[j][3]); }
            const float rstd = __builtin_amdgcn_rsqf(wave_sum(s) * (1.f / 1024.f) + EPS);
#pragma unroll
            for (int j = 0; j < 4; ++j) { const f32x4 gq = gr[64 * j];
#pragma unroll
                for (int e = 0; e < 4; ++e) xT[(256 * j + 4 * lane + e) * 16 + row] = v[j][e] * rstd * gq[e]; } }
        __syncthreads();
        for (int cg0 = blockIdx.x * 16; cg0 < 4096; cg0 += G * 16) {
            const int ci = lane & 15, kq = lane >> 4, dcol = cg0 + ci;
            const int scol = dcol < 1024 ? dcol : dcol < 2048 ? 3080 + (dcol - 1024) : dcol < 3072 ? 1024 + (dcol - 2048) : 4104 + (dcol - 3072);
            float a[16];
#pragma unroll
            for (int r = 0; r < 16; ++r) a[r] = 0.f;
            const int kbase = 128 * wave + kq;
            const float* wp = w_in + (size_t)kbase * NPROJ + scol;
#pragma unroll
            for (int ib = 0; ib < 2; ++ib) { float wv[16];
#pragma unroll
                for (int i = 0; i < 16; ++i) wv[i] = wp[(size_t)(4 * (16 * ib + i)) * NPROJ];
#pragma unroll
                for (int i = 0; i < 16; ++i) { const LAS f32x4* xp = (const LAS f32x4*)(xT + (kbase + 4 * (16 * ib + i)) * 16);
#pragma unroll
                    for (int q = 0; q < 4; ++q) { const f32x4 xv = xp[q];
#pragma unroll
                        for (int e = 0; e < 4; ++e) a[4 * q + e] += xv[e] * wv[i]; }
                    __builtin_amdgcn_sched_barrier(0); } }
#pragma unroll
            for (int r = 0; r < 16; ++r) { a[r] += __shfl_xor(a[r], 16); a[r] += __shfl_xor(a[r], 32); }
            if (kq == 0) {
#pragma unroll
                for (int r = 0; r < 16; ++r) red[(wave * 16 + r) * 16 + ci] = a[r]; }
            __syncthreads();
            if (tid < 256) { const int row = tid >> 4, cc = tid & 15, dc = cg0 + cc; float sm = 0.f;
#pragma unroll
                for (int w = 0; w < 8; ++w) sm += red[(w * 16 + row) * 16 + cc];
                bf16_t* dst = dc < 2048 ? (bf16_t*)(ws + WS_R1) + (size_t)(48 + row) * 2048 + dc : (bf16_t*)(ws + WS_R2) + (size_t)(48 + row) * 2048 + (dc - 2048);
                *dst = f2bf(sm); }
            __syncthreads();
        }
    }
    {
        LAS float* Wsm = (LAS float*)L;
#pragma unroll
        for (int b0 = 0; b0 < 48; b0 += 16) { float tv[16];
#pragma unroll
            for (int i = 0; i < 16; ++i) { const int idx = tid + 512 * (b0 + i); const int k = idx / 24, c = idx - k * 24; const int sc = c < 8 ? 2048 + c : 5128 + (c - 8); tv[i] = w_in[(size_t)k * NPROJ + sc]; }
#pragma unroll
            for (int i = 0; i < 16; ++i) { const int idx = tid + 512 * (b0 + i); const int k = idx / 24, c = idx - k * 24; Wsm[c * 1028 + k] = tv[i]; } }
        __syncthreads();
        float* GI = (float*)(ws + WS_GI); float* GF = (float*)(ws + WS_GF); float* GA = (float*)(ws + WS_GA);
        bf16_t* XN = (bf16_t*)((unsigned char*)p.out + OUT_XN);
        const float bsel = lane < 8 ? p.in[6][lane] : 0.f;
        const f32x4* gr = (const f32x4*)p.in[2] + lane;
        f32x4 g1v[4];
#pragma unroll
        for (int j = 0; j < 4; ++j) g1v[j] = gr[64 * j];
        f32x4 vn[4];
        { const int r = gw; const f32x4* xr = (const f32x4*)(r >= SEQ ? p.in[1] + (size_t)(r - SEQ) * 1024 : p.in[0] + (size_t)r * 1024) + lane;
#pragma unroll
            for (int j = 0; j < 4; ++j) vn[j] = (r < SEQ + 16) ? xr[64 * j] : (f32x4){0.f, 0.f, 0.f, 0.f}; }
        for (int r = gw; r < SEQ + 16; r += NGW) {
            const bool ismeta = r >= SEQ; const int t = ismeta ? 48 + (r - SEQ) : 64 + r;
            f32x4 v[4]; float s = 0.f;
#pragma unroll
            for (int j = 0; j < 4; ++j) { v[j] = vn[j]; s += (v[j][0] * v[j][0] + v[j][1] * v[j][1]) + (v[j][2] * v[j][2] + v[j][3] * v[j][3]); }
            { const int r2 = r + NGW; if (r2 < SEQ + 16) { const f32x4* xr = (const f32x4*)(r2 >= SEQ ? p.in[1] + (size_t)(r2 - SEQ) * 1024 : p.in[0] + (size_t)r2 * 1024) + lane;
#pragma unroll
                for (int j = 0; j < 4; ++j) vn[j] = xr[64 * j]; } }
            const float rstd = __builtin_amdgcn_rsqf(wave_sum(s) * (1.f / 1024.f) + EPS);
#pragma unroll
            for (int j = 0; j < 4; ++j) v[j] = v[j] * rstd * g1v[j];
            if (!ismeta) { u32x2* o8 = (u32x2*)(XN + (size_t)r * 1024) + lane;
#pragma unroll
                for (int j = 0; j < 4; ++j) { u32x2 o; o.x = cvt_pk_bf16(v[j][0], v[j][1]); o.y = cvt_pk_bf16(v[j][2], v[j][3]); o8[64 * j] = o; } }
            float mine = 0.f;
#pragma unroll 4
            for (int c = 0; c < 24; ++c) { float d = 0.f;
#pragma unroll
                for (int j = 0; j < 4; ++j) { const f32x4 wv = *(const LAS f32x4*)(Wsm + c * 1028 + 256 * j + 4 * lane); d += (v[j][0] * wv[0] + v[j][1] * wv[1]) + (v[j][2] * wv[2] + v[j][3] * wv[3]); }
                d = wave_sum(d); if (lane == c) mine = d; }
            if (lane < 4) GI[t * 4 + lane] = mine + bsel;
            else if (lane < 8) GF[t * 4 + lane - 4] = logsigmoidf_(mine + bsel);
            else if (lane < 24) GA[t * 16 + lane - 8] = mine;
        }
    }
}

constexpr int XL_AQ = 0, XL_BK = 17408, XL_KT = 34816, XL_F = 53248;
template <bool SINGLE>
__device__ __forceinline__ void x_phase(const Params& p, LAS unsigned char* L, const int item0, const int NIT, const int GS) {
    const int tid = threadIdx.x, lane = tid & 63, wave = __builtin_amdgcn_readfirstlane(tid >> 6), fr = lane & 15, fq = lane >> 4;
    unsigned char* ws = p.ws;
    const bf16_t* RAW = (const bf16_t*)(ws + WS_R1);
    bf16_t* AQ = (bf16_t*)(ws + WS_AQ); bf16_t* KU = (bf16_t*)(ws + WS_KU); bf16_t* WW = (bf16_t*)((unsigned char*)p.out + OUT_WW);
    const float* GI = (const float*)(ws + WS_GI); const float* GF = (const float*)(ws + WS_GF); const float* GA = (const float*)(ws + WS_GA);
    float* CHB = (float*)(ws + WS_CHB); float* CHM = (float*)(ws + WS_CHM); float* CHG = (float*)(ws + WS_CHG); float* BT = (float*)(ws + WS_BT);
    LAS bf16_t* sAq = (LAS bf16_t*)(L + XL_AQ); LAS bf16_t* sBk = (LAS bf16_t*)(L + XL_BK); LAS bf16_t* sKt = (LAS bf16_t*)(L + XL_KT);
    LAS float* sF = (LAS float*)(L + XL_F);
    LAS float* sga = sF + 256;
    LAS float* part = sF + 256 + 1024;
    const float NINF = -__builtin_inff();
#define X_DECODE(item, c, br, h) const int c = (item) >> 3, br = (((item) >> 2) ^ (c >> 5)) & 1, h = (item) & 3
    const int which = tid >> 8, u = tid & 255, d8 = (u & 15) * 8, l0 = (u >> 4) * 4;
    const int gd = tid & 127, grp = tid >> 7;
    u32x4 raw[7]; float glf = 0.f, gli = 0.f;
    bf16_t rq[16], rk[16]; f32x4 gav = (f32x4){0.f, 0.f, 0.f, 0.f};
#define X_LOAD_M(c, h) do { const int _t0 = (c) * 64; const bf16_t* _src = RAW + which * 512 + (h) * 128 + d8; \
        _Pragma("unroll") for (int _i = 0; _i < 7; ++_i) { const int _t = _t0 + l0 - 3 + _i; raw[_i] = (_t >= 48) ? *(const u32x4*)(_src + (size_t)_t * 2048) : (u32x4){0u, 0u, 0u, 0u}; } \
        if (wave >= 4) { const int _t = _t0 + lane; const bool _v = _t >= 48; glf = _v ? GF[_t * 4 + (h)] : 0.f; gli = _v ? GI[_t * 4 + (h)] : NINF; } } while (0)
#define X_LOAD_G(c, h) do { const int _t0 = (c) * 64; const int _col = (h) * 128 + gd; \
        if (tid < 256) gav = ((const f32x4*)(GA + (size_t)_t0 * 16))[tid]; \
        _Pragma("unroll") for (int _i = 0; _i < 16; ++_i) { const int _t = _t0 + grp * 16 + _i; rq[_i] = (_t >= 48) ? RAW[(size_t)_t * 2048 + 1024 + _col] : (bf16_t)0; rk[_i] = (_t >= 48) ? RAW[(size_t)_t * 2048 + 1536 + _col] : (bf16_t)0; } } while (0)

    int item = item0;
    if (item < NIT) { X_DECODE(item, c, br, h); if (br == 0) X_LOAD_M(c, h); else X_LOAD_G(c, h); }
    bool need = false;
    for (; item < NIT; item += (SINGLE ? NIT : GS)) {
        X_DECODE(item, c, br, h); const int t0 = c * 64, ix = c * 8 + br * 4 + h;
        if (need) { if (br == 0) X_LOAD_M(c, h); else X_LOAD_G(c, h); }
        need = false;
        if (!SINGLE) { const int nx = item + GS; if (nx < NIT) { X_DECODE(nx, c2, br2, h2); if (br2 != br) { if (br2 == 0) X_LOAD_M(c2, h2); else X_LOAD_G(c2, h2); } else need = true; } }
        if (br == 0) {
            const int ch0 = which * 512 + h * 128 + d8;
            const float* cw = p.in[4] + ch0; const float* cb = p.in[5] + ch0;
            f32x4 wv4[4][2];
#pragma unroll
            for (int j = 0; j < 4; ++j) { wv4[j][0] = *(const f32x4*)(cw + j * 1024); wv4[j][1] = *(const f32x4*)(cw + j * 1024 + 4); }
            const f32x4 bv0 = *(const f32x4*)cb, bv1 = *(const f32x4*)(cb + 4);
            if (wave >= 4) {
                const float lf = glf, li = gli;
                const float b = wave_scan_sum(lf);
                const float gtot = __int_as_float(__builtin_amdgcn_readlane(__float_as_int(b), 63));
                const float wl = gtot - b + li;
                const float Ml = wave_max(wl);
                const float e = __expf(wl - Ml);
                const float lib = li - b;
                const float pm = wave_scan_max(lib);
                const bool dead = (pm == NINF);
                sF[128 + 64 * (wave - 4) + lane] = e;
                if (wave == 4) {
                    sF[lane] = lib; sF[64 + lane] = dead ? 0.f : pm;
                    CHB[(c * 4 + h) * 64 + lane] = b; CHM[(c * 4 + h) * 64 + lane] = dead ? 0.f : (b + pm);
                    if (lane == 0) { CHG[(c * 4 + h) * 2] = gtot; CHG[(c * 4 + h) * 2 + 1] = Ml; } }
                asm volatile("s_waitcnt lgkmcnt(0)" ::: "memory");
            }
            {
                float res[4][8];
#pragma unroll
                for (int e2 = 0; e2 < 4; ++e2) {
#pragma unroll
                    for (int o = 0; o < 4; ++o) { float y0 = e2 < 2 ? bv0[2 * e2] : bv1[2 * e2 - 4], y1 = e2 < 2 ? bv0[2 * e2 + 1] : bv1[2 * e2 - 3];
#pragma unroll
                        for (int j = 0; j < 4; ++j) { const unsigned wv = raw[o + j][e2]; y0 += (e2 < 2 ? wv4[j][0][2 * e2] : wv4[j][1][2 * e2 - 4]) * bf_lo(wv); y1 += (e2 < 2 ? wv4[j][0][2 * e2 + 1] : wv4[j][1][2 * e2 - 3]) * bf_hi(wv); }
                        res[o][2 * e2] = siluf_(y0); res[o][2 * e2 + 1] = siluf_(y1); } }
                if (which == 0) {
#pragma unroll
                    for (int o = 0; o < 4; ++o) { u32x4 w; w.x = cvt_pk_bf16(res[o][0] * QSCALE, res[o][1] * QSCALE); w.y = cvt_pk_bf16(res[o][2] * QSCALE, res[o][3] * QSCALE);
                        w.z = cvt_pk_bf16(res[o][4] * QSCALE, res[o][5] * QSCALE); w.w = cvt_pk_bf16(res[o][6] * QSCALE, res[o][7] * QSCALE);
                        *(LAS u32x4*)(sAq + (l0 + o) * 136 + d8) = w; *(u32x4*)(AQ + (size_t)(t0 + l0 + o) * 1024 + h * 128 + d8) = w; }
                } else {
                    float ev[4];
#pragma unroll
                    for (int o = 0; o < 4; ++o) { ev[o] = sF[128 + 64 * (wave - 4) + l0 + o];
                        u32x4 w; w.x = cvt_pk_bf16(res[o][0], res[o][1]); w.y = cvt_pk_bf16(res[o][2], res[o][3]); w.z = cvt_pk_bf16(res[o][4], res[o][5]); w.w = cvt_pk_bf16(res[o][6], res[o][7]);
                        *(LAS u32x4*)(sBk + (l0 + o) * 136 + d8) = w; }
#pragma unroll
                    for (int e = 0; e < 8; ++e) { u32x2 w; w.x = cvt_pk_bf16(res[0][e] * ev[0], res[1][e] * ev[1]); w.y = cvt_pk_bf16(res[2][e] * ev[2], res[3][e] * ev[3]);
                        *(LAS u32x2*)(sKt + (d8 + e) * 72 + l0) = w; }
                }
            }
        } else {
            const int d = gd, col = h * 128 + d;
            float a2[16];
#pragma unroll
            for (int r = 0; r < 16; ++r) a2[r] = p.in[7][r * 512 + col];
            const float bias = p.in[8][col];
            if (tid < 256) ((LAS f32x4*)sga)[tid] = gav;
            LDS_BARRIER();
            float cs[16]; float run = 0.f;
#pragma unroll
            for (int i = 0; i < 16; ++i) { const int l = grp * 16 + i; float za = bias;
#pragma unroll
                for (int q = 0; q < 4; ++q) { const f32x4 gv = *(const LAS f32x4*)(sga + l * 16 + 4 * q); za += (gv[0] * a2[4 * q] + gv[1] * a2[4 * q + 1]) + (gv[2] * a2[4 * q + 2] + gv[3] * a2[4 * q + 3]); }
                const float la = (t0 + l >= 48) ? logsigmoidf_(za) * (1.f / 16.f) : 0.f;
                run += la; cs[i] = run; }
            part[grp * 128 + d] = run;
            LDS_BARRIER();
            float off = 0.f, btot = 0.f;
#pragma unroll
            for (int g2 = 0; g2 < 4; ++g2) { const float pv = part[g2 * 128 + d]; btot += pv; if (g2 < grp) off += pv; }
            if (grp == 0) BT[(c * 4 + h) * 128 + d] = btot;
            float kend[16];
#pragma unroll
            for (int i = 0; i < 16; ++i) { const int l = grp * 16 + i, t = t0 + l; const float bc = cs[i] + off;
                const float gq = bf2f(rq[i]), gk = bf2f(rk[i]);
                const bf16_t qd = f2bf(gq * QSCALE * __expf(bc));
                sAq[l * 136 + d] = qd; AQ[(size_t)t * 1024 + 512 + col] = qd;
                sBk[l * 136 + d] = f2bf(gk * __expf(-bc));
                kend[i] = gk * __expf(btot - bc); }
            u32x4 w0, w1;
            w0.x = cvt_pk_bf16(kend[0], kend[1]); w0.y = cvt_pk_bf16(kend[2], kend[3]); w0.z = cvt_pk_bf16(kend[4], kend[5]); w0.w = cvt_pk_bf16(kend[6], kend[7]);
            w1.x = cvt_pk_bf16(kend[8], kend[9]); w1.y = cvt_pk_bf16(kend[10], kend[11]); w1.z = cvt_pk_bf16(kend[12], kend[13]); w1.w = cvt_pk_bf16(kend[14], kend[15]);
            *(LAS u32x4*)(sKt + d * 72 + grp * 16) = w0; *(LAS u32x4*)(sKt + d * 72 + grp * 16 + 8) = w1;
        }
        LDS_BARRIER();
        {
            const int jt = wave & 3, sh = wave >> 2, j = jt * 16 + fr;
            const float pmj = br == 0 ? sF[64 + j] : 0.f;
#pragma unroll
            for (int q = 0; q < 2; ++q) { const int st = 2 * sh + q;
                f32x4 acc = (f32x4){0.f, 0.f, 0.f, 0.f};
                if (st <= jt) {
#pragma unroll
                    for (int ks = 0; ks < 4; ++ks) { const bf16x8 kf = *(const LAS bf16x8*)(sBk + (st * 16 + fr) * 136 + ks * 32 + fq * 8), qf = *(const LAS bf16x8*)(sAq + j * 136 + ks * 32 + fq * 8);
                        acc = MFMA16(kf, qf, acc); }
#pragma unroll
                    for (int i = 0; i < 4; ++i) { const int s2 = st * 16 + fq * 4 + i; float dd = 0.f; if (s2 <= j) dd = br == 0 ? __expf(sF[s2] - pmj) : 1.f; acc[i] = (s2 <= j) ? acc[i] * dd : 0.f; }
                }
                u32x2 w; w.x = cvt_pk_bf16(acc[0], acc[1]); w.y = cvt_pk_bf16(acc[2], acc[3]);
                *(u32x2*)(WW + (size_t)ix * 4096 + j * 64 + st * 16 + fq * 4) = w; }
        }
#pragma unroll
        for (int i = 0; i < 2; ++i) { const int pc = tid + 512 * i, row = pc >> 3, sg = pc & 7;
            *(u32x4*)(KU + (size_t)ix * 8192 + pc * 8) = *(const LAS u32x4*)(sKt + row * 72 + sg * 8); }
        LDS_BARRIER();
    }
#undef X_DECODE
#undef X_LOAD_M
#undef X_LOAD_G
}

constexpr int SL_AQ = 0, SL_W = 17408, SL_KT = 26624, SL_VT = 45056, SL_CB = 56576, SL_CH = 78336, SL_ROW = 80896;
template <bool ML, bool PASSC>
__device__ __forceinline__ void scan_item(const Params& p, LAS unsigned char* L, const int qid, const int h, const int sl, const int g) {
    constexpr int NVT = ML ? 5 : 4, NT = ML ? 3 : 2;
    constexpr int NG = PASSC ? 2 : 4, TG = 512 / NG;
    constexpr int NLQ = 1024 / TG, NLW = 512 / TG, NLK = 1024 / TG, NLV = 512 / TG;
    const int tid = threadIdx.x, lane = tid & 63, wave = __builtin_amdgcn_readfirstlane(tid >> 6), fr = lane & 15, fq = lane >> 4;
    const int br = ML ? 0 : 1; const int item = qid * 4 + sl;
    const int gi = wave / (8 / NG), gt = tid & (TG - 1);
    unsigned char* ws = p.ws;
    const bf16_t* AQ = (const bf16_t*)(ws + WS_AQ); const bf16_t* KU = (const bf16_t*)(ws + WS_KU); const bf16_t* WW = (const bf16_t*)((const unsigned char*)p.out + OUT_WW);
    const bf16_t* V = (const bf16_t*)(ws + WS_R2); bf16_t* H = (bf16_t*)(ws + WS_R1); float* HSS = (float*)(ws + WS_HSS);
    const float* CHB = (const float*)(ws + WS_CHB); const float* CHM = (const float*)(ws + WS_CHM); const float* CHG = (const float*)(ws + WS_CHG); const float* BT = (const float*)(ws + WS_BT);
    f32x4* SEG = (f32x4*)(ws + WS_SEG);
    LAS bf16_t* sAq = (LAS bf16_t*)(L + SL_AQ); LAS bf16_t* sW = (LAS bf16_t*)(L + SL_W); LAS bf16_t* sKt = (LAS bf16_t*)(L + SL_KT);
    LAS bf16_t* sVt = (LAS bf16_t*)(L + SL_VT); LAS bf16_t* sCb = (LAS bf16_t*)(L + SL_CB); LAS float* sCH = (LAS float*)(L + SL_CH); LAS float* sRow = (LAS float*)(L + SL_ROW);
    const int cs = seg_start_b(ML, g), ce = seg_start_b(ML, g + 1);
    const int dt = wave, jt = wave & 3, vh = wave >> 2;

    u32x4 rq[NLQ], rw[NLW], rk[NLK], rv[NLV]; float rs = 0.f;
#define SCAN_LOAD(c) do { const int _t0 = (c) * 64; const int _ix = (c) * 8 + br * 4 + h; \
        if (PASSC) { _Pragma("unroll") for (int _i = 0; _i < NLQ; ++_i) { const int _p = gt + TG * _i; rq[_i] = *(const u32x4*)(AQ + (size_t)(_t0 + (_p >> 4)) * 1024 + br * 512 + h * 128 + (_p & 15) * 8); } \
            _Pragma("unroll") for (int _i = 0; _i < NLW; ++_i) rw[_i] = *(const u32x4*)(WW + (size_t)_ix * 4096 + (gt + TG * _i) * 8); } \
        _Pragma("unroll") for (int _i = 0; _i < NLK; ++_i) rk[_i] = *(const u32x4*)(KU + (size_t)_ix * 8192 + (gt + TG * _i) * 8); \
        _Pragma("unroll") for (int _i = 0; _i < NLV; ++_i) { const int _p = gt + TG * _i, _l = _p & 63, _pc = _p >> 6; \
            rv[_i] = (_t0 + _l >= 48) ? *(const u32x4*)(V + (size_t)(_t0 + _l) * 2048 + br * 1024 + h * 256 + sl * 64 + _pc * 8) : (u32x4){0u, 0u, 0u, 0u}; } \
        if (gt < 128) { if (ML) { if (PASSC) rs = (gt < 64) ? CHB[((c) * 4 + h) * 64 + gt] : CHM[((c) * 4 + h) * 64 + gt - 64]; } \
        else rs = BT[(size_t)((c) * 4 + h) * 128 + gt]; } } while (0)
#define SCAN_WRITE() do { \
        if (PASSC) { _Pragma("unroll") for (int _i = 0; _i < NLQ; ++_i) { const int _p = gt + TG * _i; *(LAS u32x4*)(sAq + (_p >> 4) * 136 + (_p & 15) * 8) = rq[_i]; } \
            _Pragma("unroll") for (int _i = 0; _i < NLW; ++_i) { const int _p = gt + TG * _i; *(LAS u32x4*)(sW + (_p >> 3) * 72 + (_p & 7) * 8) = rw[_i]; } } \
        _Pragma("unroll") for (int _i = 0; _i < NLK; ++_i) { const int _p = gt + TG * _i; *(LAS u32x4*)(sKt + (_p >> 3) * 72 + (_p & 7) * 8) = rk[_i]; } \
        _Pragma("unroll") for (int _i = 0; _i < NLV; ++_i) { const int _p = gt + TG * _i, _l = _p & 63, _pc = _p >> 6; \
            _Pragma("unroll") for (int _e = 0; _e < 4; ++_e) { const unsigned _wv = rv[_i][_e]; sVt[(_pc * 8 + 2 * _e) * 72 + _l] = (bf16_t)(_wv & 0xffffu); sVt[(_pc * 8 + 2 * _e + 1) * 72 + _l] = (bf16_t)(_wv >> 16); } } \
        if ((!ML || PASSC) && gt < 128) sRow[gt] = rs; } while (0)
#pragma unroll
    for (int k = 0; k < NG; ++k) { if (gi == k && cs + k < ce) SCAN_LOAD(cs + k); }

    if (ML) { if (tid < 128) { const int row = 64 + (tid >> 3), sg = tid & 7; const unsigned one = (row == 64) ? 0x3F803F80u : 0u; *(LAS u32x4*)(sVt + row * 72 + sg * 8) = (u32x4){one, one, one, one}; }
        for (int i = tid; i < NCH * 2; i += 512) sCH[i] = CHG[(i >> 1) * 8 + h * 2 + (i & 1)]; }
    LDS_BARRIER();

    f32x4 st[NVT];
#pragma unroll
    for (int vt = 0; vt < NVT; ++vt) st[vt] = (f32x4){0.f, 0.f, 0.f, 0.f};
    float mrun = 0.f; f32x4 btacc = (f32x4){0.f, 0.f, 0.f, 0.f};
    for (int gp = 0; gp < g; ++gp) {
        const int c0 = seg_start_b(ML, gp), c1 = seg_start_b(ML, gp + 1);
        f32x4 F;
        if (ML) { float Fl = 0.f;
#pragma unroll 8
            for (int c = c0; c < c1; ++c) { const float gc = sCH[2 * c], Ml = sCH[2 * c + 1]; const float mn = fmaxf(gc + mrun, Ml); Fl += gc + mrun - mn; mrun = mn; }
            const float f = __expf(Fl); F = (f32x4){f, f, f, f}; }
        else { f32x4 s4 = (f32x4){0.f, 0.f, 0.f, 0.f}; if (PASSC) s4 = *(const f32x4*)((const float*)(ws + WS_SEGBT) + (size_t)(h * 8 + gp) * 128 + dt * 16 + fq * 4);
            F = (f32x4){__expf(s4[0]), __expf(s4[1]), __expf(s4[2]), __expf(s4[3])}; }
        if (PASSC) { const int it2 = (qid - g + gp) * 4 + sl;
#pragma unroll
            for (int vt = 0; vt < NVT; ++vt) { const f32x4 Lv = SEG[((size_t)(it2 * 8 + dt) * 5 + vt) * 64 + lane]; st[vt] = F * st[vt] + Lv; } }
    }
    if (PASSC) {
#pragma unroll
        for (int vt = 0; vt < NVT; ++vt) { u32x2 w; w.x = cvt_pk_bf16(st[vt][0], st[vt][1]); w.y = cvt_pk_bf16(st[vt][2], st[vt][3]); *(LAS u32x2*)(sCb + (vt * 16 + fr) * 136 + dt * 16 + fq * 4) = w; }
    }

    for (int c = cs; c < ce; ++c) {
        if (gi == ((c - cs) & (NG - 1))) { SCAN_WRITE(); if (c + NG < ce) SCAN_LOAD(c + NG); }
        LDS_BARRIER();
        float a_c = 1.f, u_c = 1.f, a_int = 1.f, r_int = 1.f, clampv = 1.f; f32x4 dec = (f32x4){1.f, 1.f, 1.f, 1.f};
        if (ML) { const float gc = sCH[2 * c], Ml = sCH[2 * c + 1]; const float mn = fmaxf(gc + mrun, Ml); a_c = __expf(gc + mrun - mn); u_c = __expf(Ml - mn);
            if (PASSC && c > 0) { const float bj = sRow[jt * 16 + fr], mr = sRow[64 + jt * 16 + fr]; const float mrow = fmaxf(bj + mrun, mr);
                a_int = __expf(bj + mrun - mrow); r_int = __expf(mr - mrow); clampv = __expf(-mrow); }
            mrun = mn; }
        else { const f32x4 b4 = *(const LAS f32x4*)(sRow + dt * 16 + fq * 4); dec = (f32x4){__expf(b4[0]), __expf(b4[1]), __expf(b4[2]), __expf(b4[3])}; btacc += b4; }
        if (PASSC && c > 0) {
            f32x4 ai[NT], ae[NT];
#pragma unroll
            for (int q = 0; q < NT; ++q) { ai[q] = (f32x4){0.f, 0.f, 0.f, 0.f}; ae[q] = (f32x4){0.f, 0.f, 0.f, 0.f}; }
#pragma unroll
            for (int ks = 0; ks < 2; ++ks) { const bf16x8 wf = *(const LAS bf16x8*)(sW + (jt * 16 + fr) * 72 + ks * 32 + fq * 8);
#pragma unroll
                for (int q = 0; q < NT; ++q) { const int vt = q < 2 ? 2 * vh + q : 4; const bf16x8 vf = *(const LAS bf16x8*)(sVt + (vt * 16 + fr) * 72 + ks * 32 + fq * 8); ai[q] = MFMA16(vf, wf, ai[q]); } }
#pragma unroll
            for (int ks = 0; ks < 4; ++ks) { const bf16x8 af = *(const LAS bf16x8*)(sAq + (jt * 16 + fr) * 136 + ks * 32 + fq * 8);
#pragma unroll
                for (int q = 0; q < NT; ++q) { const int vt = q < 2 ? 2 * vh + q : 4; const bf16x8 cf = *(const LAS bf16x8*)(sCb + (vt * 16 + fr) * 136 + ks * 32 + fq * 8); ae[q] = MFMA16(cf, af, ae[q]); } }
            float dn = 1.f;
            if (ML) { const float denv = a_int * ae[NT - 1][0] + r_int * ai[NT - 1][0]; const float den = __shfl(denv, fr); dn = __builtin_amdgcn_rcpf(fmaxf(fabsf(den), clampv)); }
            const int row = (c - 1) * 64 + jt * 16 + fr; float ss = 0.f;
#pragma unroll
            for (int q = 0; q < 2; ++q) { f32x4 hv;
#pragma unroll
                for (int i = 0; i < 4; ++i) { hv[i] = ML ? (a_int * ae[q][i] + r_int * ai[q][i]) * dn : (ae[q][i] + ai[q][i]); ss += hv[i] * hv[i]; }
                u32x2 w; w.x = cvt_pk_bf16(hv[0], hv[1]); w.y = cvt_pk_bf16(hv[2], hv[3]);
                *(u32x2*)(H + (size_t)row * 2048 + br * 1024 + h * 256 + sl * 64 + (2 * vh + q) * 16 + fq * 4) = w; }
            ss += __shfl_xor(ss, 16); ss += __shfl_xor(ss, 32);
            if (fq == 0) HSS[(size_t)row * 64 + br * 32 + h * 8 + sl * 2 + vh] = ss;
        }
        f32x4 dl[NVT];
#pragma unroll
        for (int vt = 0; vt < NVT; ++vt) dl[vt] = (f32x4){0.f, 0.f, 0.f, 0.f};
#pragma unroll
        for (int ks = 0; ks < 2; ++ks) { const bf16x8 kf = *(const LAS bf16x8*)(sKt + (dt * 16 + fr) * 72 + ks * 32 + fq * 8);
#pragma unroll
            for (int vt = 0; vt < NVT; ++vt) { const bf16x8 vf = *(const LAS bf16x8*)(sVt + (vt * 16 + fr) * 72 + ks * 32 + fq * 8); dl[vt] = MFMA16(kf, vf, dl[vt]); } }
        LDS_BARRIER();
#pragma unroll
        for (int vt = 0; vt < NVT; ++vt) { if (ML) st[vt] = st[vt] * a_c + dl[vt] * u_c; else st[vt] = st[vt] * dec + dl[vt];
            if (PASSC) { u32x2 w; w.x = cvt_pk_bf16(st[vt][0], st[vt][1]); w.y = cvt_pk_bf16(st[vt][2], st[vt][3]); *(LAS u32x2*)(sCb + (vt * 16 + fr) * 136 + dt * 16 + fq * 4) = w; } }
    }
#undef SCAN_LOAD
#undef SCAN_WRITE
    if (!PASSC) {
#pragma unroll
        for (int vt = 0; vt < NVT; ++vt) SEG[((size_t)(item * 8 + dt) * 5 + vt) * 64 + lane] = st[vt];
        if (!ML && sl == 0 && fr == 0) *(f32x4*)((float*)(ws + WS_SEGBT) + (size_t)(h * 8 + g) * 128 + dt * 16 + fq * 4) = btacc;
    }
    LDS_BARRIER();
}

__device__ __forceinline__ void scan_phase(const Params& p, LAS unsigned char* L, const bool passC) {
    for (int b = blockIdx.x; b < 256; b += gridDim.x) {
        const int x = b & 7, y = b >> 3, qid = x + 8 * (y >> 2), sl = y & 3;
        const bool ml = qid < 4 * NSEG_M;
        const int qq = ml ? qid : qid - 4 * NSEG_M, ns = ml ? NSEG_M : NSEG_G, h = qq / ns, g = qq - h * ns;
        if (!passC && g == ns - 1) continue;
        if (passC) { if (ml) scan_item<true, true>(p, L, qid, h, sl, g); else scan_item<false, true>(p, L, qid, h, sl, g); }
        else { if (ml) scan_item<true, false>(p, L, qid, h, sl, g); else scan_item<false, false>(p, L, qid, h, sl, g); }
    }
}

__global__ void __launch_bounds__(512, 2) fwd_megakernel(Params p) {
    extern __shared__ __attribute__((aligned(16))) unsigned char lds_raw[];
    LAS unsigned char* L = (LAS unsigned char*)lds_raw;
    cg::grid_group grid = cg::this_grid();
    const int lo = p.ph_lo, hi = p.ph_hi, G = gridDim.x;
    unsigned char* ws = p.ws;
#define IN(k) (lo <= (k) && (k) < hi)
#define SEAM(k) do { if (IN(k) && IN((k) + 1)) xcd_barrier(bar); } while (0)
    if (lo < 0) grid.sync();
    if (threadIdx.x < 16) ((LAS unsigned*)(L + MISC_OFF))[threadIdx.x] = 0u;
    __syncthreads();
    XcdBarrier bar = xcd_barrier_post((unsigned*)(ws + WS_BAR), (volatile LAS unsigned*)(L + MISC_OFF));
    if (IN(0)) p0_prologue(p, L);
    SEAM(0);
    if (IN(1)) { pg8::Gemm g{(const bf16_t*)((const unsigned char*)p.out + OUT_XN), (const bf16_t*)(ws + WS_WTA), SEQ, 4096, 1024, 1024, 0, 0};
        pg8::StaticOrder S; S.init(SEQ, 4096, G, (int)blockIdx.x);
        pg8::EpiQKV E{(bf16_t*)(ws + WS_R1), (bf16_t*)(ws + WS_R2)};
        pg8::gemm_phase<pg8::EpiQKV, pg8::StaticOrder>(L, g, S, E); }
    SEAM(1);
    if (IN(2)) x_phase<false>(p, L, (int)blockIdx.x, (G == 256 ? (NCH - 1) * 8 : NCH * 8), G);
    SEAM(2);
    if (IN(3)) {
        if (G == 256) { const int b = blockIdx.x, x = b & 7, y = b >> 3, qid = x + 8 * (y >> 2), sl = y & 3; const bool ml = qid < 4 * NSEG_M;
            const int qq = ml ? qid : qid - 4 * NSEG_M, ns = ml ? NSEG_M : NSEG_G, hh = qq / ns, gg = qq - hh * ns;
            if (gg == ns - 1 && sl == 0) { const int it = (NCH - 1) * 8 + (ml ? 0 : 4) + hh; x_phase<true>(p, L, it, it + 1, 256); } }
        scan_phase(p, L, false);
    }
    SEAM(3);
    if (IN(4)) scan_phase(p, L, true);
    SEAM(4);
    if (IN(5)) { pg8::Gemm g{(const bf16_t*)((const unsigned char*)p.out + OUT_XN), (const bf16_t*)(ws + WS_WTB), SEQ, 4096, 1024, 1024, 0, 0};
        pg8::StaticOrder S; S.init(SEQ, 4096, G, (int)blockIdx.x);
        pg8::EpiGate E{(bf16_t*)(ws + WS_R1), (bf16_t*)(ws + WS_R2), (const float*)(ws + WS_HSS), p.in[9], p.in[10]};
        pg8::gemm_phase<pg8::EpiGate, pg8::StaticOrder>(L, g, S, E); }
    SEAM(5);
    if (IN(6)) { pg8::Gemm g{(const bf16_t*)(ws + WS_R1), (const bf16_t*)(ws + WS_WTBM), SEQ, 1024, 1024, 2048, (size_t)1024 * 2, (size_t)2 * MiB};
        pg8::TwoPassOrder S; S.init(SEQ, 1024, G, (int)blockIdx.x);
        pg8::EpiMerge E{(bf16_t*)(ws + WS_AQ), (const bf16_t*)(ws + WS_R2)};
        pg8::gemm_phase<pg8::EpiMerge, pg8::TwoPassOrder>(L, g, S, E); }
    SEAM(6);
    if (IN(7)) { pg8::Gemm g{(const bf16_t*)(ws + WS_AQ), (const bf16_t*)(ws + WS_WTO), SEQ, 1024, 1024, 1024, 0, 0};
        pg8::StaticOrder S; S.init(SEQ, 1024, G, (int)blockIdx.x);
        pg8::EpiResid E{p.in[0], (bf16_t*)(ws + WS_KU), (float*)(ws + WS_SS1)};
        pg8::gemm_phase<pg8::EpiResid, pg8::StaticOrder>(L, g, S, E); }
    SEAM(7);
    if (IN(8)) { pg8::Gemm g{(const bf16_t*)(ws + WS_KU), (const bf16_t*)(ws + WS_WTFF), SEQ, 2 * DFF, 1024, 1024, 0, 0};
        pg8::StaticOrder S; S.init(SEQ, 2 * DFF, G, (int)blockIdx.x);
        pg8::EpiFF E{(bf16_t*)(ws + WS_FF), (const float*)(ws + WS_SS1)};
        pg8::gemm_phase<pg8::EpiFF, pg8::StaticOrder>(L, g, S, E); }
    SEAM(8);
    if (IN(9)) { pg8::Gemm g{(const bf16_t*)(ws + WS_FF), (const bf16_t*)(ws + WS_WTD), SEQ, 1024, DFF, DFF, 0, 0};
        pg8::StaticOrder S; S.init(SEQ, 1024, G, (int)blockIdx.x);
        pg8::EpiFinal E{p.out, (const bf16_t*)(ws + WS_KU), p.in[18], (float*)(ws + WS_SS2), (unsigned*)(ws + WS_PCNT)};
        pg8::gemm_phase<pg8::EpiFinal, pg8::StaticOrder>(L, g, S, E); }
#undef IN
#undef SEAM
}

extern "C" void kernel_launch(void* const* d_in, const int* in_sizes, int n_in, void* d_out, int out_size, void* d_ws, size_t ws_size, hipStream_t stream) {
    static int grid = 0;
    if (grid == 0) {
        if (n_in != 19 || out_size != SEQ * DM || ws_size < WS_END) { fprintf(stderr, "kernel_launch: unexpected sizes (n_in %d out %d ws %zu)\n", n_in, out_size, ws_size); grid = -1; return; }
        int dev = 0, cus = 0, per_cu = 0;
        (void)hipGetDevice(&dev); (void)hipDeviceGetAttribute(&cus, hipDeviceAttributeMultiprocessorCount, dev);
        if (hipFuncSetAttribute((const void*)fwd_megakernel, hipFuncAttributeMaxDynamicSharedMemorySize, LDS_BYTES) != hipSuccess) { fprintf(stderr, "kernel_launch: hipFuncSetAttribute failed\n"); grid = -1; return; }
        if (hipOccupancyMaxActiveBlocksPerMultiprocessor(&per_cu, (const void*)fwd_megakernel, 512, LDS_BYTES) != hipSuccess || per_cu < 1) { fprintf(stderr, "kernel_launch: occupancy query says %d\n", per_cu); per_cu = 1; }
        (void)hipGetLastError();
        grid = cus * 1;
        if (grid <= 0) grid = 256;
    }
    if (grid < 0) return;
    if (hipMemsetAsync(d_ws, 0, CTL_ZERO_BYTES, stream) != hipSuccess) { fprintf(stderr, "kernel_launch: memset failed\n"); return; }
    Params a{};
    for (int i = 0; i < 19; ++i) a.in[i] = (const float*)d_in[i];
    a.out = (float*)d_out; a.ws = (unsigned char*)d_ws;
#if N_LAUNCH_MODE == 1
    a.ph_lo = 0; a.ph_hi = 10;
    void* args[] = {&a};
    hipError_t e = hipLaunchCooperativeKernel((const void*)fwd_megakernel, dim3(grid), dim3(512), args, LDS_BYTES, stream);
    if (e != hipSuccess) fprintf(stderr, "cooperative launch failed: %s (grid %d)\n", hipGetErrorString(e), grid);
#else
    for (int ph = 0; ph < 10; ++ph) { a.ph_lo = ph; a.ph_hi = ph + 1;
        hipLaunchKernelGGL(fwd_megakernel, dim3(grid), dim3(512), LDS_BYTES, stream, a); }
#endif
}
```

```cpp
#include <hip/hip_runtime.h>
#include <hip/hip_cooperative_groups.h>
#include <cstdio>
#include <cstdint>
namespace cg = cooperative_groups;

#define LAS __attribute__((address_space(3)))
typedef unsigned short bf16_t;
typedef short bf16x8 __attribute__((ext_vector_type(8)));
typedef float f32x4 __attribute__((ext_vector_type(4)));
typedef unsigned u32x4 __attribute__((ext_vector_type(4)));
typedef unsigned u32x2 __attribute__((ext_vector_type(2)));

#ifndef N_LAUNCH_MODE
#define N_LAUNCH_MODE 1
#endif

constexpr int DM = 1024, SEQ = 16384, TP = SEQ + 64, NCH = 257, NPROJ = 8216, DFF = 2816;
constexpr float EPS = 1e-6f;
constexpr float QSCALE = 0.08838834764831845f;
constexpr int NSEG_M = 9, NSEG_G = 7;
__host__ __device__ constexpr int seg_start_b(bool ml, int g) { return ml ? (g * 257 + 4) / 9 : (g * 257 + 3) / 7; }

constexpr size_t MiB = 1u << 20;
constexpr size_t WS_SS1 = 0, WS_SS2 = 65536, WS_BAR = 131072, WS_PCNT = 147456, CTL_ZERO_BYTES = 163840;
constexpr size_t WS_GI = 1 * MiB, WS_GF = 1 * MiB + 512 * 1024, WS_GA = 2 * MiB;
constexpr size_t WS_HSS = 4 * MiB;
constexpr size_t WS_CHB = 8 * MiB, WS_CHM = 8 * MiB + 512 * 1024, WS_CHG = 9 * MiB, WS_BT = 9 * MiB + 65536, WS_SEGBT = 9 * MiB + 768 * 1024;
constexpr size_t WS_WTA = 10 * MiB, WS_WTB = 18 * MiB, WS_WTBM = 26 * MiB, WS_WTO = 30 * MiB, WS_WTFF = 32 * MiB, WS_WTD = 43 * MiB;
constexpr size_t WS_R1 = 49 * MiB;
constexpr size_t WS_R2 = 114 * MiB;
constexpr size_t WS_AQ = 179 * MiB;
constexpr size_t WS_KU = 212 * MiB;
constexpr size_t WS_SEG = 245 * MiB;
constexpr size_t WS_FF = WS_R1;
constexpr size_t WS_END = 256 * MiB;
constexpr size_t OUT_XN = 0, OUT_WW = 32 * MiB;

constexpr int LDS_BYTES = 147456, MISC_OFF = 146432;

typedef float f32x2_t __attribute__((ext_vector_type(2)));
typedef __bf16 bf16x2_t __attribute__((ext_vector_type(2)));
__device__ __forceinline__ unsigned cvt_pk_bf16(float lo, float hi) { const f32x2_t v = {lo, hi}; const bf16x2_t b = __builtin_convertvector(v, bf16x2_t); return __builtin_bit_cast(unsigned, b); }
__device__ __forceinline__ float bf_lo(unsigned u) { return __uint_as_float(u << 16); }
__device__ __forceinline__ float bf_hi(unsigned u) { return __uint_as_float(u & 0xffff0000u); }
__device__ __forceinline__ float bf2f(bf16_t b) { return __uint_as_float(((unsigned)b) << 16); }
__device__ __forceinline__ bf16_t f2bf(float f) { return (bf16_t)(cvt_pk_bf16(f, 0.f) & 0xffffu); }
#define DPP_F(old, src, ctrl, rmask, bc) __int_as_float(__builtin_amdgcn_update_dpp(__float_as_int(old), __float_as_int(src), (ctrl), (rmask), 0xf, (bc)))
__device__ __forceinline__ float wave_sum(float v) {
    v += DPP_F(0.f, v, 0xB1, 0xf, true);
    v += DPP_F(0.f, v, 0x4E, 0xf, true);
    v += DPP_F(0.f, v, 0x141, 0xf, true);
    v += DPP_F(0.f, v, 0x140, 0xf, true);
    v += DPP_F(0.f, v, 0x142, 0xa, false);
    v += DPP_F(0.f, v, 0x143, 0xc, false);
    return __int_as_float(__builtin_amdgcn_readlane(__float_as_int(v), 63));
}
__device__ __forceinline__ float wave_max(float v) {
    v = fmaxf(v, DPP_F(v, v, 0xB1, 0xf, false));
    v = fmaxf(v, DPP_F(v, v, 0x4E, 0xf, false));
    v = fmaxf(v, DPP_F(v, v, 0x141, 0xf, false));
    v = fmaxf(v, DPP_F(v, v, 0x140, 0xf, false));
    v = fmaxf(v, DPP_F(v, v, 0x142, 0xa, false));
    v = fmaxf(v, DPP_F(v, v, 0x143, 0xc, false));
    return __int_as_float(__builtin_amdgcn_readlane(__float_as_int(v), 63));
}
__device__ __forceinline__ float wave_scan_sum(float v) {
    v += DPP_F(0.f, v, 0x111, 0xf, true); v += DPP_F(0.f, v, 0x112, 0xf, true); v += DPP_F(0.f, v, 0x114, 0xf, true); v += DPP_F(0.f, v, 0x118, 0xf, true);
    v += DPP_F(0.f, v, 0x142, 0xa, false); v += DPP_F(0.f, v, 0x143, 0xc, false);
    return v;
}
__device__ __forceinline__ float wave_scan_max(float v) {
    v = fmaxf(v, DPP_F(v, v, 0x111, 0xf, false)); v = fmaxf(v, DPP_F(v, v, 0x112, 0xf, false)); v = fmaxf(v, DPP_F(v, v, 0x114, 0xf, false)); v = fmaxf(v, DPP_F(v, v, 0x118, 0xf, false));
    v = fmaxf(v, DPP_F(v, v, 0x142, 0xa, false)); v = fmaxf(v, DPP_F(v, v, 0x143, 0xc, false));
    return v;
}
__device__ __forceinline__ float sigmoidf_(float x) { return __builtin_amdgcn_rcpf(1.f + __expf(-x)); }
__device__ __forceinline__ float siluf_(float x) { return x * __builtin_amdgcn_rcpf(1.f + __expf(-x)); }
__device__ __forceinline__ float logsigmoidf_(float z) { return fminf(z, 0.f) - __logf(1.f + __expf(-fabsf(z))); }
#define LDS_BARRIER() do { asm volatile("s_waitcnt lgkmcnt(0)" ::: "memory"); __builtin_amdgcn_s_barrier(); asm volatile("" ::: "memory"); } while (0)
#define MFMA16(a, b, c) __builtin_amdgcn_mfma_f32_16x16x32_bf16((a), (b), (c), 0, 0, 0)

namespace pg8 {
constexpr int BM = 256, BK = 64, HALF = 128, HTB = HALF * BK * 2, NXCD = 8, WGM = 1;
__host__ __device__ __forceinline__ int lds_byte(int r, int c) { const int st = (r >> 4) * 2 + (c >> 5), rr = r & 15, cc = c & 31, ob = rr * 64 + cc * 2; return st * 1024 + (ob ^ (((ob >> 9) & 1) << 5)); }
__host__ __device__ __forceinline__ void stage_rc(int b, int& R, int& C) { const int st = b / 1024, sb = b % 1024, swz = sb ^ (((sb >> 9) & 1) << 5); R = (st >> 1) * 16 + swz / 64; C = (st & 1) * 32 + (swz % 64) / 2; }
__host__ __device__ __forceinline__ int perm32(int rho) { const int n = rho >> 4, i = rho & 15; return 8 * (i >> 2) + 4 * n + (i & 3); }

struct Unit { int pm, pn, ks; };
struct Gemm { const bf16_t* A; const bf16_t* Bt; int M, N, K, lda; size_t ksA, ksB; };

struct StaticOrder {
    int nM, nN, nwg, G, c;
    __device__ void init(int M, int N, int G_, int c_) { nM = M / BM; nN = N / BM; nwg = nM * nN; G = G_; c = c_; }
    __device__ bool next(int i, Unit& u) const {
        const long Lx = (long)i * G + c; if (Lx >= nwg) return false;
        int wgid = (int)Lx; { const int q = nwg / NXCD, r = nwg % NXCD, xcd = wgid % NXCD, off = wgid / NXCD; wgid = (xcd < r ? xcd * (q + 1) : r * (q + 1) + (xcd - r) * q) + off; }
        const int nig = WGM * nN, gid = wgid / nig, fm = gid * WGM, gsz = (nM - fm) < WGM ? (nM - fm) : WGM;
        u.pm = fm + ((wgid % nig) % gsz); u.pn = (wgid % nig) / gsz; u.ks = 0; return true;
    }
};
struct TwoPassOrder {
    int ntile, nN, G, c;
    __device__ void init(int M, int N, int G_, int c_) { nN = N / BM; ntile = (M / BM) * nN; G = G_; c = c_; }
    __device__ bool next(int i, Unit& u) const {
        const int cc = (G % 8 == 0) ? (c % 8) * (G / 8) + c / 8 : c;
        const int tl = (i >> 1) * G + cc; if (tl >= ntile) return false;
        u.pm = tl / nN; u.pn = tl % nN; u.ks = i & 1; return true;
    }
};

template <class Epi, class Sched>
__device__ __forceinline__ void gemm_phase(LAS unsigned char* lds, const Gemm g, const Sched& S, const Epi& E) {
    const int tid = threadIdx.x, wid = __builtin_amdgcn_readfirstlane(tid >> 6), lane = tid & 63, wr = wid >> 2, wc = wid & 3, fr = lane & 15, fq = lane >> 4;
    const int K = g.K, nt = K / BK;
    unsigned voffA[2], voffB[2];
#pragma unroll
    for (int i = 0; i < 2; ++i) { int R, C; stage_rc(tid * 16 + i * 8192, R, C); const int Rb = (R & ~31) + perm32(R & 31);
        voffA[i] = (unsigned)(R * g.lda + C) * 2u; voffB[i] = (unsigned)(Rb * K + C) * 2u; }
    const size_t kstep = (size_t)(BK * 2);
    const size_t hstepA = (size_t)HALF * g.lda * 2, hstepB = (size_t)HALF * K * 2;
    const size_t tstepA = 2 * hstepA, tstepB = 2 * hstepB;
    const unsigned ldsw = (unsigned)wid * 1024u;
    const int aoff = lds_byte(wr * 64 + fr, fq * 8), boff = lds_byte(wc * 32 + fr, fq * 8);
#define PG8_SA(b, h) (((b) * 2 + (h)) * HTB)
#define PG8_SB(b, h) ((4 + (b) * 2 + (h)) * HTB)
#define PG8_STAGE(bufoff, gbase, voff) do { _Pragma("unroll") for (int _i = 0; _i < 2; ++_i) \
        __builtin_amdgcn_global_load_lds((const unsigned*)((const char*)(gbase) + (voff)[_i]), (LAS unsigned*)(lds + (bufoff) + ldsw + _i * 8192), 16, 0, 0); } while (0)
#define PG8_LDA(dst, b, h) do { _Pragma("unroll") for (int m = 0; m < 4; ++m) _Pragma("unroll") for (int k = 0; k < 2; ++k) dst[m][k] = *(const LAS bf16x8*)(lds + PG8_SA(b, h) + aoff + m * 2048 + k * 1024); } while (0)
#define PG8_LDB(dst, b, h) do { _Pragma("unroll") for (int n = 0; n < 2; ++n) _Pragma("unroll") for (int k = 0; k < 2; ++k) dst[n][k] = *(const LAS bf16x8*)(lds + PG8_SB(b, h) + boff + n * 2048 + k * 1024); } while (0)
#define PG8_MMA(ai, bj, At, Bt) do { __builtin_amdgcn_s_setprio(1); _Pragma("unroll") for (int m = 0; m < 4; ++m) _Pragma("unroll") for (int n = 0; n < 2; ++n) _Pragma("unroll") for (int k = 0; k < 2; ++k) \
        acc[ai][bj][m][n] = __builtin_amdgcn_mfma_f32_16x16x32_bf16(Bt[n][k], At[m][k], acc[ai][bj][m][n], 0, 0, 0); __builtin_amdgcn_s_setprio(0); } while (0)
#define PG8_WAIT_V(n) asm volatile("s_waitcnt vmcnt(" #n ")" ::: "memory")
#define PG8_WAIT_L(n) asm volatile("s_waitcnt lgkmcnt(" #n ")" ::: "memory")
#define PG8_BAR __builtin_amdgcn_s_barrier()
#define PG8_SCHED __builtin_amdgcn_sched_barrier(0)
    Unit cur, nxt; int ui = 0;
    if (!S.next(0, cur)) return;
    f32x4 acc[2][2][4][2];
#pragma unroll
    for (int a = 0; a < 2; ++a)
#pragma unroll
        for (int b = 0; b < 2; ++b)
#pragma unroll
            for (int m = 0; m < 4; ++m)
#pragma unroll
                for (int n = 0; n < 2; ++n) acc[a][b][m][n] = (f32x4){0.f, 0.f, 0.f, 0.f};
    bf16x8 At[4][2], B0[2][2], B1[2][2];
    const char* cA = (const char*)g.A + (size_t)cur.pm * tstepA + (size_t)cur.ks * g.ksA; const char* cB = (const char*)g.Bt + (size_t)cur.pn * tstepB + (size_t)cur.ks * g.ksB;
    PG8_STAGE(PG8_SB(0, 0), cB, voffB); PG8_STAGE(PG8_SB(0, 1), cB + hstepB, voffB); PG8_STAGE(PG8_SA(0, 0), cA, voffA); PG8_STAGE(PG8_SA(0, 1), cA + hstepA, voffA);
    if (wr == 1) PG8_BAR;
    PG8_WAIT_V(2); PG8_BAR;
    PG8_STAGE(PG8_SB(1, 0), cB + kstep, voffB); PG8_STAGE(PG8_SA(1, 0), cA + kstep, voffA); PG8_STAGE(PG8_SB(1, 1), cB + hstepB + kstep, voffB);
    PG8_WAIT_V(6); PG8_BAR;
    for (;;) {
        const bool has_next = S.next(ui + 1, nxt);
        const char* nA = has_next ? (const char*)g.A + (size_t)nxt.pm * tstepA + (size_t)nxt.ks * g.ksA : cA; const char* nB = has_next ? (const char*)g.Bt + (size_t)nxt.pn * tstepB + (size_t)nxt.ks * g.ksB : cB;
        for (int t = 0; t < nt; t += 2) {
            const bool last = (t == nt - 2);
            const char* a1 = cA + (size_t)(t + 1) * kstep;
            const char* a2 = last ? nA : cA + (size_t)(t + 2) * kstep; const char* b2 = last ? nB : cB + (size_t)(t + 2) * kstep;
            const char* a3 = a2 + kstep; const char* b3 = b2 + kstep;
            PG8_LDB(B0, 0, 0); PG8_LDB(B1, 0, 1); PG8_SCHED; PG8_LDA(At, 0, 0); PG8_STAGE(PG8_SA(1, 1), a1 + hstepA, voffA);
            PG8_WAIT_V(8); PG8_WAIT_L(0); PG8_BAR; PG8_MMA(0, 0, At, B0); PG8_MMA(0, 1, At, B1); PG8_BAR; PG8_SCHED;
            PG8_LDA(At, 0, 1); PG8_STAGE(PG8_SB(0, 0), b2, voffB); PG8_STAGE(PG8_SB(0, 1), b2 + hstepB, voffB); PG8_STAGE(PG8_SA(0, 0), a2, voffA);
            PG8_WAIT_V(8); PG8_WAIT_L(0); PG8_BAR; PG8_MMA(1, 0, At, B0); PG8_MMA(1, 1, At, B1); PG8_BAR; PG8_SCHED;
            PG8_LDB(B0, 1, 0); PG8_LDB(B1, 1, 1); PG8_SCHED; PG8_LDA(At, 1, 0); PG8_STAGE(PG8_SA(0, 1), a2 + hstepA, voffA);
            PG8_WAIT_V(8); PG8_WAIT_L(0); PG8_BAR; PG8_MMA(0, 0, At, B0); PG8_MMA(0, 1, At, B1); PG8_BAR; PG8_SCHED;
            PG8_LDA(At, 1, 1); PG8_STAGE(PG8_SB(1, 0), b3, voffB); PG8_STAGE(PG8_SB(1, 1), b3 + hstepB, voffB); PG8_STAGE(PG8_SA(1, 0), a3, voffA);
            PG8_WAIT_V(8); PG8_WAIT_L(0); PG8_BAR; PG8_MMA(1, 0, At, B0); PG8_MMA(1, 1, At, B1); PG8_BAR; PG8_SCHED;
        }
        if (wr == 0) PG8_BAR;
        E(acc, cur, wr, wc, fr, fq);
        if (!has_next) break;
#pragma unroll
        for (int a = 0; a < 2; ++a)
#pragma unroll
            for (int b = 0; b < 2; ++b)
#pragma unroll
                for (int m = 0; m < 4; ++m)
#pragma unroll
                    for (int n = 0; n < 2; ++n) acc[a][b][m][n] = (f32x4){0.f, 0.f, 0.f, 0.f};
        cur = nxt; cA = nA; cB = nB; ++ui;
        if (wr == 1) PG8_BAR;
    }
    PG8_WAIT_V(0);
    PG8_BAR;
#undef PG8_SA
#undef PG8_SB
#undef PG8_STAGE
#undef PG8_LDA
#undef PG8_LDB
#undef PG8_MMA
#undef PG8_WAIT_V
#undef PG8_WAIT_L
#undef PG8_BAR
#undef PG8_SCHED
}

__device__ __forceinline__ u32x4 pack8(const f32x4 v0, const f32x4 v1) { u32x4 w; w.x = cvt_pk_bf16(v0[0], v0[1]); w.y = cvt_pk_bf16(v0[2], v0[3]); w.z = cvt_pk_bf16(v1[0], v1[1]); w.w = cvt_pk_bf16(v1[2], v1[3]); return w; }
__device__ __forceinline__ void unpack8(const u32x4 w, f32x4& v0, f32x4& v1) { v0 = (f32x4){bf_lo(w.x), bf_hi(w.x), bf_lo(w.y), bf_hi(w.y)}; v1 = (f32x4){bf_lo(w.z), bf_hi(w.z), bf_lo(w.w), bf_hi(w.w)}; }

struct EpiQKV {
    bf16_t* rawqk; bf16_t* vbuf;
    __device__ __forceinline__ void operator()(const f32x4 (&acc)[2][2][4][2], const Unit& u, int wr, int wc, int fr, int fq) const {
        int colt = u.pn * BM; bf16_t* base = rawqk; if (colt >= 2048) { base = vbuf; colt -= 2048; }
        const int row0 = 64 + u.pm * BM + wr * 64 + fr, col0 = colt + wc * 32 + 8 * fq;
#pragma unroll
        for (int ai = 0; ai < 2; ++ai)
#pragma unroll
            for (int m = 0; m < 4; ++m) { bf16_t* rowp = base + (size_t)(row0 + ai * HALF + m * 16) * 2048 + col0;
#pragma unroll
                for (int bj = 0; bj < 2; ++bj) *(u32x4*)(rowp + bj * HALF) = pack8(acc[ai][bj][m][0], acc[ai][bj][m][1]); }
    }
};

struct EpiGate {
    bf16_t* H; bf16_t* G2; const float* hss; const float* mg; const float* gg;
    __device__ __forceinline__ void operator()(const f32x4 (&acc)[2][2][4][2], const Unit& u, int wr, int wc, int fr, int fq) const {
        const int row0 = u.pm * BM + wr * 64 + fr;
        if (u.pn >= 8) {
            const int col0 = (u.pn - 8) * BM + wc * 32 + 8 * fq;
#pragma unroll
            for (int ai = 0; ai < 2; ++ai)
#pragma unroll
                for (int m = 0; m < 4; ++m) { bf16_t* rowp = G2 + (size_t)(row0 + ai * HALF + m * 16) * 2048 + col0;
#pragma unroll
                    for (int bj = 0; bj < 2; ++bj) { f32x4 v0 = acc[ai][bj][m][0], v1 = acc[ai][bj][m][1];
#pragma unroll
                        for (int e = 0; e < 4; ++e) { v0[e] = sigmoidf_(v0[e]); v1[e] = sigmoidf_(v1[e]); }
                        *(u32x4*)(rowp + bj * HALF) = pack8(v0, v1); } }
        } else {
            const int br = u.pn >> 2, head = u.pn & 3;
            const float* gain = (br ? gg : mg) + head * 256 + wc * 32 + 8 * fq;
            f32x4 gv[2][2];
#pragma unroll
            for (int bj = 0; bj < 2; ++bj) { gv[bj][0] = *(const f32x4*)(gain + bj * HALF); gv[bj][1] = *(const f32x4*)(gain + bj * HALF + 4); }
            const int col0 = br * 1024 + head * 256 + wc * 32 + 8 * fq;
#pragma unroll
            for (int ai = 0; ai < 2; ++ai) {
                float rs4[4];
                {   f32x4 sa[4], sb[4];
#pragma unroll
                    for (int m = 0; m < 4; ++m) { const int row = row0 + ai * HALF + m * 16;
                        sa[m] = *(const f32x4*)(hss + (size_t)row * 64 + br * 32 + head * 8); sb[m] = *(const f32x4*)(hss + (size_t)row * 64 + br * 32 + head * 8 + 4); }
#pragma unroll
                    for (int m = 0; m < 4; ++m) { const f32x4 s0 = sa[m], s1 = sb[m];
                        const float ssum = ((s0[0] + s0[1]) + (s0[2] + s0[3])) + ((s1[0] + s1[1]) + (s1[2] + s1[3]));
                        rs4[m] = __builtin_amdgcn_rsqf(ssum * (1.f / 256.f) + EPS); } }
                u32x4 hraw[4][2];
#pragma unroll
                for (int m = 0; m < 4; ++m)
#pragma unroll
                    for (int bj = 0; bj < 2; ++bj) hraw[m][bj] = *(const u32x4*)(H + (size_t)(row0 + ai * HALF + m * 16) * 2048 + col0 + bj * HALF);
#pragma unroll
                for (int m = 0; m < 4; ++m) { const int row = row0 + ai * HALF + m * 16;
                    const float rstd = rs4[m];
                    bf16_t* rowp = H + (size_t)row * 2048 + col0;
#pragma unroll
                    for (int bj = 0; bj < 2; ++bj) { f32x4 a0 = acc[ai][bj][m][0], a1 = acc[ai][bj][m][1], h0, h1;
                        unpack8(hraw[m][bj], h0, h1);
#pragma unroll
                        for (int e = 0; e < 4; ++e) { const float g0 = br ? siluf_(a0[e]) : sigmoidf_(a0[e]), g1 = br ? siluf_(a1[e]) : sigmoidf_(a1[e]);
                            h0[e] = h0[e] * rstd * gv[bj][0][e] * g0; h1[e] = h1[e] * rstd * gv[bj][1][e] * g1; }
                        *(u32x4*)(rowp + bj * HALF) = pack8(h0, h1); } } }
        }
    }
};

struct EpiMerge {
    bf16_t* MG; const bf16_t* G2;
    __device__ __forceinline__ void operator()(const f32x4 (&acc)[2][2][4][2], const Unit& u, int wr, int wc, int fr, int fq) const {
        const int row0 = u.pm * BM + wr * 64 + fr, col0 = u.pn * BM + wc * 32 + 8 * fq;
#pragma unroll
        for (int ai = 0; ai < 2; ++ai) {
            u32x4 gr[4][2], pr[4][2];
#pragma unroll
            for (int m = 0; m < 4; ++m)
#pragma unroll
                for (int bj = 0; bj < 2; ++bj) { const int row = row0 + ai * HALF + m * 16;
                    gr[m][bj] = *(const u32x4*)(G2 + (size_t)row * 2048 + u.ks * 1024 + col0 + bj * HALF);
                    pr[m][bj] = u.ks ? *(const u32x4*)(MG + (size_t)row * 1024 + col0 + bj * HALF) : (u32x4){0u, 0u, 0u, 0u}; }
#pragma unroll
            for (int m = 0; m < 4; ++m) { const int row = row0 + ai * HALF + m * 16; bf16_t* rowp = MG + (size_t)row * 1024 + col0;
#pragma unroll
                for (int bj = 0; bj < 2; ++bj) { f32x4 g0, g1, p0, p1; unpack8(gr[m][bj], g0, g1); unpack8(pr[m][bj], p0, p1);
                    *(u32x4*)(rowp + bj * HALF) = pack8(acc[ai][bj][m][0] * g0 + p0, acc[ai][bj][m][1] * g1 + p1); } } }
    }
};

struct EpiResid {
    const float* resid; bf16_t* h1b; float* sumsq;
    __device__ __forceinline__ void operator()(const f32x4 (&acc)[2][2][4][2], const Unit& u, int wr, int wc, int fr, int fq) const {
        const int row0 = u.pm * BM + wr * 64 + fr, col0 = u.pn * BM + wc * 32 + 8 * fq;
#pragma unroll
        for (int ai = 0; ai < 2; ++ai) {
            f32x4 rv[4][2][2];
#pragma unroll
            for (int m = 0; m < 4; ++m)
#pragma unroll
                for (int bj = 0; bj < 2; ++bj) { const size_t o = (size_t)(row0 + ai * HALF + m * 16) * 1024 + col0 + bj * HALF; rv[m][bj][0] = *(const f32x4*)(resid + o); rv[m][bj][1] = *(const f32x4*)(resid + o + 4); }
#pragma unroll
            for (int m = 0; m < 4; ++m) { const int row = row0 + ai * HALF + m * 16; float ss = 0.f;
#pragma unroll
                for (int bj = 0; bj < 2; ++bj) { const size_t o = (size_t)row * 1024 + col0 + bj * HALF;
                    const f32x4 v0 = rv[m][bj][0] + acc[ai][bj][m][0], v1 = rv[m][bj][1] + acc[ai][bj][m][1];
                    ss += (v0[0] * v0[0] + v0[1] * v0[1]) + (v0[2] * v0[2] + v0[3] * v0[3]) + (v1[0] * v1[0] + v1[1] * v1[1]) + (v1[2] * v1[2] + v1[3] * v1[3]);
                    *(u32x4*)(h1b + o) = pack8(v0, v1); }
                ss += __shfl_xor(ss, 16); ss += __shfl_xor(ss, 32);
                if (fq == 0) __hip_atomic_fetch_add(sumsq + row, ss, __ATOMIC_RELAXED, __HIP_MEMORY_SCOPE_AGENT); } }
    }
};

struct EpiFF {
    bf16_t* FF; const float* sumsq;
    __device__ __forceinline__ void operator()(const f32x4 (&acc)[2][2][4][2], const Unit& u, int wr, int wc, int fr, int fq) const {
        const int row0 = u.pm * BM + wr * 64 + fr, col0 = u.pn * HALF + wc * 32 + 8 * fq;
        float ssq[2][4];
#pragma unroll
        for (int ai = 0; ai < 2; ++ai)
#pragma unroll
            for (int m = 0; m < 4; ++m) ssq[ai][m] = sumsq[row0 + ai * HALF + m * 16];
#pragma unroll
        for (int ai = 0; ai < 2; ++ai)
#pragma unroll
            for (int m = 0; m < 4; ++m) { const int row = row0 + ai * HALF + m * 16;
                const float r = __builtin_amdgcn_rsqf(ssq[ai][m] * (1.f / 1024.f) + EPS);
                f32x4 v0, v1;
#pragma unroll
                for (int e = 0; e < 4; ++e) { v0[e] = siluf_(r * acc[ai][0][m][0][e]) * (r * acc[ai][1][m][0][e]); v1[e] = siluf_(r * acc[ai][0][m][1][e]) * (r * acc[ai][1][m][1][e]); }
                *(u32x4*)(FF + (size_t)row * DFF + col0) = pack8(v0, v1); }
    }
};

struct EpiFinal {
    float* out; const bf16_t* h1b; const float* fg; float* sumsq; unsigned* cnt;
    __device__ __forceinline__ void operator()(f32x4 (&acc)[2][2][4][2], const Unit& u, int wr, int wc, int fr, int fq) const {
        const int row0 = u.pm * BM + wr * 64 + fr, col0 = u.pn * BM + wc * 32 + 8 * fq;
#pragma unroll
        for (int ai = 0; ai < 2; ++ai) {
            u32x4 hb[4][2];
#pragma unroll
            for (int m = 0; m < 4; ++m)
#pragma unroll
                for (int bj = 0; bj < 2; ++bj) hb[m][bj] = *(const u32x4*)(h1b + (size_t)(row0 + ai * HALF + m * 16) * 1024 + col0 + bj * HALF);
#pragma unroll
            for (int m = 0; m < 4; ++m) { const int row = row0 + ai * HALF + m * 16; float ss = 0.f;
#pragma unroll
                for (int bj = 0; bj < 2; ++bj) { const size_t o = (size_t)row * 1024 + col0 + bj * HALF;
                    f32x4 r0, r1; unpack8(hb[m][bj], r0, r1);
                    const f32x4 v0 = r0 + acc[ai][bj][m][0], v1 = r1 + acc[ai][bj][m][1];
                    acc[ai][bj][m][0] = v0; acc[ai][bj][m][1] = v1;
                    ss += (v0[0] * v0[0] + v0[1] * v0[1]) + (v0[2] * v0[2] + v0[3] * v0[3]) + (v1[0] * v1[0] + v1[1] * v1[1]) + (v1[2] * v1[2] + v1[3] * v1[3]); }
                ss += __shfl_xor(ss, 16); ss += __shfl_xor(ss, 32);
                if (fq == 0) __hip_atomic_fetch_add(sumsq + row, ss, __ATOMIC_RELAXED, __HIP_MEMORY_SCOPE_AGENT); } }
        asm volatile("s_waitcnt vmcnt(0)" ::: "memory");
        __syncthreads();
        if (threadIdx.x == 0) {
            __threadfence();
            unsigned* c = cnt + u.pm * 64;
            __hip_atomic_fetch_add(c, 1u, __ATOMIC_RELAXED, __HIP_MEMORY_SCOPE_AGENT);
            unsigned sp = 0;
            while (__hip_atomic_load(c, __ATOMIC_RELAXED, __HIP_MEMORY_SCOPE_AGENT) < 4u) { __builtin_amdgcn_s_sleep(1); if (++sp > (1u << 22)) break; }
            __threadfence();
        }
        __syncthreads();
        f32x4 gv[2][2];
#pragma unroll
        for (int bj = 0; bj < 2; ++bj) { gv[bj][0] = *(const f32x4*)(fg + col0 + bj * HALF); gv[bj][1] = *(const f32x4*)(fg + col0 + bj * HALF + 4); }
        float ssv[2][4];
#pragma unroll
        for (int ai = 0; ai < 2; ++ai)
#pragma unroll
            for (int m = 0; m < 4; ++m) ssv[ai][m] = __hip_atomic_load(sumsq + row0 + ai * HALF + m * 16, __ATOMIC_RELAXED, __HIP_MEMORY_SCOPE_AGENT);
#pragma unroll
        for (int ai = 0; ai < 2; ++ai)
#pragma unroll
            for (int m = 0; m < 4; ++m) { const int row = row0 + ai * HALF + m * 16;
                const float rs = __builtin_amdgcn_rsqf(ssv[ai][m] * (1.f / 1024.f) + EPS);
#pragma unroll
                for (int bj = 0; bj < 2; ++bj) { const size_t o = (size_t)row * 1024 + col0 + bj * HALF;
                    *(f32x4*)(out + o) = acc[ai][bj][m][0] * rs * gv[bj][0]; *(f32x4*)(out + o + 4) = acc[ai][bj][m][1] * rs * gv[bj][1]; } }
    }
};
}


#define XB_TMO      128
#define XB_XCNT(j)  (256  + 64 * (j))
#define XB_XSUB(j)  (1280 + 64 * (j))
#define XB_XGEN(j)  (2304 + 64 * (j))
#define XB_TOP      3328
#define XB_TOPGEN   3392
#define XCD_BAR_WORDS 3456
#define XB_SPIN_CAP (1u << 18)
__device__ __forceinline__ unsigned xb_ld(unsigned* p)              { return __hip_atomic_load(p, __ATOMIC_RELAXED, __HIP_MEMORY_SCOPE_AGENT); }
__device__ __forceinline__ unsigned xb_add(unsigned* p, unsigned v) { return __hip_atomic_fetch_add(p, v, __ATOMIC_RELAXED, __HIP_MEMORY_SCOPE_AGENT); }
__device__ __forceinline__ unsigned xb_xcc_id() { return (unsigned)__builtin_amdgcn_s_getreg((3 << 11) | 20) & 0xFu; }
#define XB_SPIN(cond, bar) do { unsigned _sp = 0; while (cond) { __builtin_amdgcn_s_sleep(1); \
    if ((++_sp & 255u) == 0u) { if (xb_ld(&(bar)[XB_TMO])) break; if (_sp > XB_SPIN_CAP) { atomicAdd(&(bar)[XB_TMO], 1u); break; } } } } while (0)
struct XcdBarrier { unsigned* bar; unsigned x; volatile LAS unsigned* st; };
__device__ __forceinline__ XcdBarrier xcd_barrier_post(unsigned* bar, volatile LAS unsigned* st) {
    XcdBarrier b; b.bar = bar; b.x = xb_xcc_id(); b.st = st;
    if (threadIdx.x == 0) (void)xb_add(&bar[XB_XCNT(b.x)], 1u);
    return b;
}
__device__ __forceinline__ void xcd_barrier_complete(unsigned* bar, unsigned x, unsigned& nloc, unsigned& nx) {
    const unsigned G = gridDim.x * gridDim.y * gridDim.z;
    unsigned sum, cnt, mine, sp = 0u;
    for (;;) {
        sum = 0u; cnt = 0u; mine = 0u;
#pragma unroll
        for (unsigned j = 0; j < 16; ++j) { const unsigned c = xb_ld(&bar[XB_XCNT(j)]); sum += c; cnt += (c > 0u) ? 1u : 0u; mine = (j == x) ? c : mine; }
        if (sum == G) break;
        __builtin_amdgcn_s_sleep(1);
        if ((++sp & 255u) == 0u) { if (xb_ld(&bar[XB_TMO])) break; if (sp > XB_SPIN_CAP) { atomicAdd(&bar[XB_TMO], 1u); break; } }
    }
    nloc = mine > 0u ? mine : 1u; nx = cnt > 0u ? cnt : 1u;
}
__device__ __forceinline__ void xcd_barrier(const XcdBarrier& b) {
    asm volatile("s_waitcnt vmcnt(0)" ::: "memory");
    __syncthreads();
    if (threadIdx.x == 0) {
        unsigned* bar = b.bar;
        __builtin_amdgcn_s_waitcnt(0);
        unsigned nloc = b.st[0], nx = b.st[1];
        if (nloc == 0u) { xcd_barrier_complete(bar, b.x, nloc, nx); b.st[0] = nloc; b.st[1] = nx; }
        const unsigned old = xb_add(&bar[XB_XSUB(b.x)], 1u);
        const unsigned gen = old / nloc;
        if (old + 1u == (gen + 1u) * nloc) {
            __builtin_amdgcn_fence(__ATOMIC_RELEASE, "agent");
            asm volatile("s_waitcnt vmcnt(0)" ::: "memory");
            const unsigned og = xb_add(&bar[XB_TOP], 1u);
            const unsigned tg = og / nx;
            if (og + 1u == (tg + 1u) * nx) xb_add(&bar[XB_TOPGEN], 1u);
            else XB_SPIN(xb_ld(&bar[XB_TOPGEN]) == tg, bar);
            __builtin_amdgcn_fence(__ATOMIC_ACQUIRE, "agent");
            xb_add(&bar[XB_XGEN(b.x)], 1u);
            asm volatile("s_waitcnt vmcnt(0)" ::: "memory");
        } else {
            XB_SPIN(xb_ld(&bar[XB_XGEN(b.x)]) == gen, bar);
            __builtin_amdgcn_fence(__ATOMIC_ACQUIRE, "agent");
            asm volatile("s_waitcnt vmcnt(0)" ::: "memory");
        }
    }
    __syncthreads();
}

struct Params { const float* in[19]; float* out; unsigned char* ws; int ph_lo, ph_hi; };

__device__ __forceinline__ void transpose_item(const float* W, int ldw, int K, bf16_t* WT, int kb, int nb, LAS float* scr, int lane, const float* ksc) {
    const int k0 = 64 * kb, n0 = 32 * nb;
    const float* Wl = W + (size_t)(k0 + (lane >> 5)) * ldw + n0 + (lane & 31);
#pragma unroll
    for (int hh = 0; hh < 2; ++hh) { float tv[16];
#pragma unroll
        for (int i = 0; i < 16; ++i) tv[i] = Wl[(size_t)(2 * (16 * hh + i)) * ldw];
        if (ksc) {
#pragma unroll
            for (int i = 0; i < 16; ++i) tv[i] *= ksc[k0 + 2 * (16 * hh + i) + (lane >> 5)]; }
#pragma unroll
        for (int i = 0; i < 16; ++i) { const int kk = 2 * (16 * hh + i) + (lane >> 5); scr[kk * 33 + (lane & 31)] = tv[i]; } }
    asm volatile("s_waitcnt lgkmcnt(0)" ::: "memory");
    const int c = lane & 7;
#pragma unroll
    for (int j = 0; j < 4; ++j) { const int n = (lane >> 3) + 8 * j; const LAS float* s = scr + (8 * c) * 33 + n;
        u32x4 o; o.x = cvt_pk_bf16(s[0 * 33], s[1 * 33]); o.y = cvt_pk_bf16(s[2 * 33], s[3 * 33]); o.z = cvt_pk_bf16(s[4 * 33], s[5 * 33]); o.w = cvt_pk_bf16(s[6 * 33], s[7 * 33]);
        *(u32x4*)(WT + (size_t)(n0 + n) * K + k0 + 8 * c) = o; }
    asm volatile("s_waitcnt lgkmcnt(0)" ::: "memory");
}

__device__ __forceinline__ void p0_prologue(const Params& p, LAS unsigned char* L) {
    const int tid = threadIdx.x, lane = tid & 63, wave = __builtin_amdgcn_readfirstlane(tid >> 6);
    const int G = gridDim.x, gw = blockIdx.x * 8 + wave, NGW = G * 8;
    unsigned char* ws = p.ws;
    const float* w_in = p.in[3];
    {
        LAS float* scr = (LAS float*)(L + wave * 8448);
        constexpr int NITEMS = 3072 + 1024 + 1536 + 2816 + 1408;
        for (int it = gw; it < NITEMS; it += NGW) {
            int r = it; const float* src; int ldw, K = 1024, kb, nb; bf16_t* dst; const float* ksc = nullptr;
            if (r < 3072) { const int pc = r >> 9; r &= 511; kb = r >> 5; nb = r & 31; ldw = NPROJ;
                const int so = pc == 0 ? 0 : pc == 1 ? 3080 : pc == 2 ? 1024 : pc == 3 ? 4104 : pc == 4 ? 2056 : 5144;
                src = w_in + so; dst = (bf16_t*)(ws + (pc < 4 ? WS_WTA : WS_WTB)) + (size_t)(pc < 4 ? pc : pc - 4) * 1048576; }
            else if ((r -= 3072) < 1024) { kb = r >> 6; nb = r & 63; ldw = NPROJ; src = w_in + 6168; dst = (bf16_t*)(ws + WS_WTB) + (size_t)2 * 1048576; }
            else if ((r -= 1024) < 1536) { const int pc = r >> 9; r &= 511; kb = r >> 5; nb = r & 31; ldw = 1024; src = p.in[11 + pc]; dst = (bf16_t*)(ws + WS_WTBM) + (size_t)pc * 1048576; }
            else if ((r -= 1536) < 2816) { const int q = r >> 6; r &= 63; kb = r >> 2; nb = r & 3; const int i = q >> 1, isup = q & 1; ldw = DFF;
                src = p.in[15 + isup] + 128 * i; dst = (bf16_t*)(ws + WS_WTFF) + (size_t)(256 * i + 128 * isup) * 1024; ksc = p.in[14]; }
            else { r -= 2816; kb = r >> 5; nb = r & 31; ldw = 1024; K = DFF; src = p.in[17]; dst = (bf16_t*)(ws + WS_WTD); }
            transpose_item(src, ldw, K, dst, kb, nb, scr, lane, ksc);
        }
    }
    __syncthreads();
    {
        LAS float* xT = (LAS float*)L;
        LAS float* red = (LAS float*)(L + 65536);
#pragma unroll
        for (int rr = 0; rr < 2; ++rr) { const int row = 2 * wave + rr; const f32x4* xr = (const f32x4*)(p.in[1] + (size_t)row * 1024) + lane; const f32x4* gr = (const f32x4*)p.in[2] + lane;
            f32x4 v[4]; float s = 0.f;
#pragma unroll
            for (int j = 0; j < 4; ++j) { v[j] = xr[64 * j]; s += (v[j][0] * v[j][0] + v[j][1] * v[j][1]) + (v[j][2] * v[j][2] + v[j][3] * v[j][3]); }
            const float rstd = __builtin_amdgcn_rsqf(wave_sum(s) * (1.f / 1024.f) + EPS);
#pragma unroll
            for (int j = 0; j < 4; ++j) { const f32x4 gq = gr[64 * j];
#pragma unroll
                for (int e = 0; e < 4; ++e) xT[(256 * j + 4 * lane + e) * 16 + row] = v[j][e] * rstd * gq[e]; } }
        __syncthreads();
        for (int cg0 = blockIdx.x * 16; cg0 < 4096; cg0 += G * 16) {
            const int ci = lane & 15, kq = lane >> 4, dcol = cg0 + ci;
            const int scol = dcol < 1024 ? dcol : dcol < 2048 ? 3080 + (dcol - 1024) : dcol < 3072 ? 1024 + (dcol - 2048) : 4104 + (dcol - 3072);
            float a[16];
#pragma unroll
            for (int r = 0; r < 16; ++r) a[r] = 0.f;
            const int kbase = 128 * wave + kq;
            const float* wp = w_in + (size_t)kbase * NPROJ + scol;
#pragma unroll
            for (int ib = 0; ib < 2; ++ib) { float wv[16];
#pragma unroll
                for (int i = 0; i < 16; ++i) wv[i] = wp[(size_t)(4 * (16 * ib + i)) * NPROJ];
#pragma unroll
                for (int i = 0; i < 16; ++i) { const LAS f32x4* xp = (const LAS f32x4*)(xT + (kbase + 4 * (16 * ib + i)) * 16);
#pragma unroll
                    for (int q = 0; q < 4; ++q) { const f32x4 xv = xp[q];
#pragma unroll
                        for (int e = 0; e < 4; ++e) a[4 * q + e] += xv[e] * wv[i]; }
                    __builtin_amdgcn_sched_barrier(0); } }
#pragma unroll
            for (int r = 0; r < 16; ++r) { a[r] += __shfl_xor(a[r], 16); a[r] += __shfl_xor(a[r], 32); }
            if (kq == 0) {
#pragma unroll
                for (int r = 0; r < 16; ++r) red[(wave * 16 + r) * 16 + ci] = a[r]; }
            __syncthreads();
            if (tid < 256) { const int row = tid >> 4, cc = tid & 15, dc = cg0 + cc; float sm = 0.f;
#pragma unroll
                for (int w = 0; w < 8; ++w) sm += red[(w * 16 + row) * 16 + cc];
                bf16_t* dst = dc < 2048 ? (bf16_t*)(ws + WS_R1) + (size_t)(48 + row) * 2048 + dc : (bf16_t*)(ws + WS_R2) + (size_t)(48 + row) * 2048 + (dc - 2048);
                *dst = f2bf(sm); }
            __syncthreads();
        }
    }
    {
        LAS float* Wsm = (LAS float*)L;
#pragma unroll
        for (int b0 = 0; b0 < 48; b0 += 16) { float tv[16];
#pragma unroll
            for (int i = 0; i < 16; ++i) { const int idx = tid + 512 * (b0 + i); const int k = idx / 24, c = idx - k * 24; const int sc = c < 8 ? 2048 + c : 5128 + (c - 8); tv[i] = w_in[(size_t)k * NPROJ + sc]; }
#pragma unroll
            for (int i = 0; i < 16; ++i) { const int idx = tid + 512 * (b0 + i); const int k = idx / 24, c = idx - k * 24; Wsm[c * 1028 + k] = tv[i]; } }
        __syncthreads();
        float* GI = (float*)(ws + WS_GI); float* GF = (float*)(ws + WS_GF); float* GA = (float*)(ws + WS_GA);
        bf16_t* XN = (bf16_t*)((unsigned char*)p.out + OUT_XN);
        const float bsel = lane < 8 ? p.in[6][lane] : 0.f;
        const f32x4* gr = (const f32x4*)p.in[2] + lane;
        f32x4 g1v[4];
#pragma unroll
        for (int j = 0; j < 4; ++j) g1v[j] = gr[64 * j];
        f32x4 vn[4];
        { const int r = gw; const f32x4* xr = (const f32x4*)(r >= SEQ ? p.in[1] + (size_t)(r - SEQ) * 1024 : p.in[0] + (size_t)r * 1024) + lane;
#pragma unroll
            for (int j = 0; j < 4; ++j) vn[j] = (r < SEQ + 16) ? xr[64 * j] : (f32x4){0.f, 0.f, 0.f, 0.f}; }
        for (int r = gw; r < SEQ + 16; r += NGW) {
            const bool ismeta = r >= SEQ; const int t = ismeta ? 48 + (r - SEQ) : 64 + r;
            f32x4 v[4]; float s = 0.f;
#pragma unroll
            for (int j = 0; j < 4; ++j) { v[j] = vn[j]; s += (v[j][0] * v[j][0] + v[j][1] * v[j][1]) + (v[j][2] * v[j][2] + v[j][3] * v[j][3]); }
            { const int r2 = r + NGW; if (r2 < SEQ + 16) { const f32x4* xr = (const f32x4*)(r2 >= SEQ ? p.in[1] + (size_t)(r2 - SEQ) * 1024 : p.in[0] + (size_t)r2 * 1024) + lane;
#pragma unroll
                for (int j = 0; j < 4; ++j) vn[j] = xr[64 * j]; } }
            const float rstd = __builtin_amdgcn_rsqf(wave_sum(s) * (1.f / 1024.f) + EPS);
#pragma unroll
            for (int j = 0; j < 4; ++j) v[j] = v[j] * rstd * g1v[j];
            if (!ismeta) { u32x2* o8 = (u32x2*)(XN + (size_t)r * 1024) + lane;
#pragma unroll
                for (int j = 0; j < 4; ++j) { u32x2 o; o.x = cvt_pk_bf16(v[j][0], v[j][1]); o.y = cvt_pk_bf16(v[j][2], v[j][3]); o8[64 * j] = o; } }
            float mine = 0.f;
#pragma unroll 4
            for (int c = 0; c < 24; ++c) { float d = 0.f;
#pragma unroll
                for (int j = 0; j < 4; ++j) { const f32x4 wv = *(const LAS f32x4*)(Wsm + c * 1028 + 256 * j + 4 * lane); d += (v[j][0] * wv[0] + v[j][1] * wv[1]) + (v[j][2] * wv[2] + v[j][3] * wv[3]); }
                d = wave_sum(d); if (lane == c) mine = d; }
            if (lane < 4) GI[t * 4 + lane] = mine + bsel;
            else if (lane < 8) GF[t * 4 + lane - 4] = logsigmoidf_(mine + bsel);
            else if (lane < 24) GA[t * 16 + lane - 8] = mine;
        }
    }
}

constexpr int XL_AQ = 0, XL_BK = 17408, XL_KT = 34816, XL_F = 53248;
template <bool SINGLE>
__device__ __forceinline__ void x_phase(const Params& p, LAS unsigned char* L, const int item0, const int NIT, const int GS) {
    const int tid = threadIdx.x, lane = tid & 63, wave = __builtin_amdgcn_readfirstlane(tid >> 6), fr = lane & 15, fq = lane >> 4;
    unsigned char* ws = p.ws;
    const bf16_t* RAW = (const bf16_t*)(ws + WS_R1);
    bf16_t* AQ = (bf16_t*)(ws + WS_AQ); bf16_t* KU = (bf16_t*)(ws + WS_KU); bf16_t* WW = (bf16_t*)((unsigned char*)p.out + OUT_WW);
    const float* GI = (const float*)(ws + WS_GI); const float* GF = (const float*)(ws + WS_GF); const float* GA = (const float*)(ws + WS_GA);
    float* CHB = (float*)(ws + WS_CHB); float* CHM = (float*)(ws + WS_CHM); float* CHG = (float*)(ws + WS_CHG); float* BT = (float*)(ws + WS_BT);
    LAS bf16_t* sAq = (LAS bf16_t*)(L + XL_AQ); LAS bf16_t* sBk = (LAS bf16_t*)(L + XL_BK); LAS bf16_t* sKt = (LAS bf16_t*)(L + XL_KT);
    LAS float* sF = (LAS float*)(L + XL_F);
    LAS float* sga = sF + 256;
    LAS float* part = sF + 256 + 1024;
    const float NINF = -__builtin_inff();
#define X_DECODE(item, c, br, h) const int c = (item) >> 3, br = (((item) >> 2) ^ (c >> 5)) & 1, h = (item) & 3
    const int which = tid >> 8, u = tid & 255, d8 = (u & 15) * 8, l0 = (u >> 4) * 4;
    const int gd = tid & 127, grp = tid >> 7;
    u32x4 raw[7]; float glf = 0.f, gli = 0.f;
    bf16_t rq[16], rk[16]; f32x4 gav = (f32x4){0.f, 0.f, 0.f, 0.f};
#define X_LOAD_M(c, h) do { const int _t0 = (c) * 64; const bf16_t* _src = RAW + which * 512 + (h) * 128 + d8; \
        _Pragma("unroll") for (int _i = 0; _i < 7; ++_i) { const int _t = _t0 + l0 - 3 + _i; raw[_i] = (_t >= 48) ? *(const u32x4*)(_src + (size_t)_t * 2048) : (u32x4){0u, 0u, 0u, 0u}; } \
        if (wave >= 4) { const int _t = _t0 + lane; const bool _v = _t >= 48; glf = _v ? GF[_t * 4 + (h)] : 0.f; gli = _v ? GI[_t * 4 + (h)] : NINF; } } while (0)
#define X_LOAD_G(c, h) do { const int _t0 = (c) * 64; const int _col = (h) * 128 + gd; \
        if (tid < 256) gav = ((const f32x4*)(GA + (size_t)_t0 * 16))[tid]; \
        _Pragma("unroll") for (int _i = 0; _i < 16; ++_i) { const int _t = _t0 + grp * 16 + _i; rq[_i] = (_t >= 48) ? RAW[(size_t)_t * 2048 + 1024 + _col] : (bf16_t)0; rk[_i] = (_t >= 48) ? RAW[(size_t)_t * 2048 + 1536 + _col] : (bf16_t)0; } } while (0)

    int item = item0;
    if (item < NIT) { X_DECODE(item, c, br, h); if (br == 0) X_LOAD_M(c, h); else X_LOAD_G(c, h); }
    bool need = false;
    for (; item < NIT; item += (SINGLE ? NIT : GS)) {
        X_DECODE(item, c, br, h); const int t0 = c * 64, ix = c * 8 + br * 4 + h;
        if (need) { if (br == 0) X_LOAD_M(c, h); else X_LOAD_G(c, h); }
        need = false;
        if (!SINGLE) { const int nx = item + GS; if (nx < NIT) { X_DECODE(nx, c2, br2, h2); if (br2 != br) { if (br2 == 0) X_LOAD_M(c2, h2); else X_LOAD_G(c2, h2); } else need = true; } }
        if (br == 0) {
            const int ch0 = which * 512 + h * 128 + d8;
            const float* cw = p.in[4] + ch0; const float* cb = p.in[5] + ch0;
            f32x4 wv4[4][2];
#pragma unroll
            for (int j = 0; j < 4; ++j) { wv4[j][0] = *(const f32x4*)(cw + j * 1024); wv4[j][1] = *(const f32x4*)(cw + j * 1024 + 4); }
            const f32x4 bv0 = *(const f32x4*)cb, bv1 = *(const f32x4*)(cb + 4);
            if (wave >= 4) {
                const float lf = glf, li = gli;
                const float b = wave_scan_sum(lf);
                const float gtot = __int_as_float(__builtin_amdgcn_readlane(__float_as_int(b), 63));
                const float wl = gtot - b + li;
                const float Ml = wave_max(wl);
                const float e = __expf(wl - Ml);
                const float lib = li - b;
                const float pm = wave_scan_max(lib);
                const bool dead = (pm == NINF);
                sF[128 + 64 * (wave - 4) + lane] = e;
                if (wave == 4) {
                    sF[lane] = lib; sF[64 + lane] = dead ? 0.f : pm;
                    CHB[(c * 4 + h) * 64 + lane] = b; CHM[(c * 4 + h) * 64 + lane] = dead ? 0.f : (b + pm);
                    if (lane == 0) { CHG[(c * 4 + h) * 2] = gtot; CHG[(c * 4 + h) * 2 + 1] = Ml; } }
                asm volatile("s_waitcnt lgkmcnt(0)" ::: "memory");
            }
            {
                float res[4][8];
#pragma unroll
                for (int e2 = 0; e2 < 4; ++e2) {
#pragma unroll
                    for (int o = 0; o < 4; ++o) { float y0 = e2 < 2 ? bv0[2 * e2] : bv1[2 * e2 - 4], y1 = e2 < 2 ? bv0[2 * e2 + 1] : bv1[2 * e2 - 3];
#pragma unroll
                        for (int j = 0; j < 4; ++j) { const unsigned wv = raw[o + j][e2]; y0 += (e2 < 2 ? wv4[j][0][2 * e2] : wv4[j][1][2 * e2 - 4]) * bf_lo(wv); y1 += (e2 < 2 ? wv4[j][0][2 * e2 + 1] : wv4[j][1][2 * e2 - 3]) * bf_hi(wv); }
                        res[o][2 * e2] = siluf_(y0); res[o][2 * e2 + 1] = siluf_(y1); } }
                if (which == 0) {
#pragma unroll
                    for (int o = 0; o < 4; ++o) { u32x4 w; w.x = cvt_pk_bf16(res[o][0] * QSCALE, res[o][1] * QSCALE); w.y = cvt_pk_bf16(res[o][2] * QSCALE, res[o][3] * QSCALE);
                        w.z = cvt_pk_bf16(res[o][4] * QSCALE, res[o][5] * QSCALE); w.w = cvt_pk_bf16(res[o][6] * QSCALE, res[o][7] * QSCALE);
                        *(LAS u32x4*)(sAq + (l0 + o) * 136 + d8) = w; *(u32x4*)(AQ + (size_t)(t0 + l0 + o) * 1024 + h * 128 + d8) = w; }
                } else {
                    float ev[4];
#pragma unroll
                    for (int o = 0; o < 4; ++o) { ev[o] = sF[128 + 64 * (wave - 4) + l0 + o];
                        u32x4 w; w.x = cvt_pk_bf16(res[o][0], res[o][1]); w.y = cvt_pk_bf16(res[o][2], res[o][3]); w.z = cvt_pk_bf16(res[o][4], res[o][5]); w.w = cvt_pk_bf16(res[o][6], res[o][7]);
                        *(LAS u32x4*)(sBk + (l0 + o) * 136 + d8) = w; }
#pragma unroll
                    for (int e = 0; e < 8; ++e) { u32x2 w; w.x = cvt_pk_bf16(res[0][e] * ev[0], res[1][e] * ev[1]); w.y = cvt_pk_bf16(res[2][e] * ev[2], res[3][e] * ev[3]);
                        *(LAS u32x2*)(sKt + (d8 + e) * 72 + l0) = w; }
                }
            }
        } else {
            const int d = gd, col = h * 128 + d;
            float a2[16];
#pragma unroll
            for (int r = 0; r < 16; ++r) a2[r] = p.in[7][r * 512 + col];
            const float bias = p.in[8][col];
            if (tid < 256) ((LAS f32x4*)sga)[tid] = gav;
            LDS_BARRIER();
            float cs[16]; float run = 0.f;
#pragma unroll
            for (int i = 0; i < 16; ++i) { const int l = grp * 16 + i; float za = bias;
#pragma unroll
                for (int q = 0; q < 4; ++q) { const f32x4 gv = *(const LAS f32x4*)(sga + l * 16 + 4 * q); za += (gv[0] * a2[4 * q] + gv[1] * a2[4 * q + 1]) + (gv[2] * a2[4 * q + 2] + gv[3] * a2[4 * q + 3]); }
                const float la = (t0 + l >= 48) ? logsigmoidf_(za) * (1.f / 16.f) : 0.f;
                run += la; cs[i] = run; }
            part[grp * 128 + d] = run;
            LDS_BARRIER();
            float off = 0.f, btot = 0.f;
#pragma unroll
            for (int g2 = 0; g2 < 4; ++g2) { const float pv = part[g2 * 128 + d]; btot += pv; if (g2 < grp) off += pv; }
            if (grp == 0) BT[(c * 4 + h) * 128 + d] = btot;
            float kend[16];
#pragma unroll
            for (int i = 0; i < 16; ++i) { const int l = grp * 16 + i, t = t0 + l; const float bc = cs[i] + off;
                const float gq = bf2f(rq[i]), gk = bf2f(rk[i]);
                const bf16_t qd = f2bf(gq * QSCALE * __expf(bc));
                sAq[l * 136 + d] = qd; AQ[(size_t)t * 1024 + 512 + col] = qd;
                sBk[l * 136 + d] = f2bf(gk * __expf(-bc));
                kend[i] = gk * __expf(btot - bc); }
            u32x4 w0, w1;
            w0.x = cvt_pk_bf16(kend[0], kend[1]); w0.y = cvt_pk_bf16(kend[2], kend[3]); w0.z = cvt_pk_bf16(kend[4], kend[5]); w0.w = cvt_pk_bf16(kend[6], kend[7]);
            w1.x = cvt_pk_bf16(kend[8], kend[9]); w1.y = cvt_pk_bf16(kend[10], kend[11]); w1.z = cvt_pk_bf16(kend[12], kend[13]); w1.w = cvt_pk_bf16(kend[14], kend[15]);
            *(LAS u32x4*)(sKt + d * 72 + grp * 16) = w0; *(LAS u32x4*)(sKt + d * 72 + grp * 16 + 8) = w1;
        }
        LDS_BARRIER();
        {
            const int jt = wave & 3, sh = wave >> 2, j = jt * 16 + fr;
            const float pmj = br == 0 ? sF[64 + j] : 0.f;
#pragma unroll
            for (int q = 0; q < 2; ++q) { const int st = 2 * sh + q;
                f32x4 acc = (f32x4){0.f, 0.f, 0.f, 0.f};
                if (st <= jt) {
#pragma unroll
                    for (int ks = 0; ks < 4; ++ks) { const bf16x8 kf = *(const LAS bf16x8*)(sBk + (st * 16 + fr) * 136 + ks * 32 + fq * 8), qf = *(const LAS bf16x8*)(sAq + j * 136 + ks * 32 + fq * 8);
                        acc = MFMA16(kf, qf, acc); }
#pragma unroll
                    for (int i = 0; i < 4; ++i) { const int s2 = st * 16 + fq * 4 + i; float dd = 0.f; if (s2 <= j) dd = br == 0 ? __expf(sF[s2] - pmj) : 1.f; acc[i] = (s2 <= j) ? acc[i] * dd : 0.f; }
                }
                u32x2 w; w.x = cvt_pk_bf16(acc[0], acc[1]); w.y = cvt_pk_bf16(acc[2], acc[3]);
                *(u32x2*)(WW + (size_t)ix * 4096 + j * 64 + st * 16 + fq * 4) = w; }
        }
#pragma unroll
        for (int i = 0; i < 2; ++i) { const int pc = tid + 512 * i, row = pc >> 3, sg = pc & 7;
            *(u32x4*)(KU + (size_t)ix * 8192 + pc * 8) = *(const LAS u32x4*)(sKt + row * 72 + sg * 8); }
        LDS_BARRIER();
    }
#undef X_DECODE
#undef X_LOAD_M
#undef X_LOAD_G
}

constexpr int SL_AQ = 0, SL_W = 17408, SL_KT = 26624, SL_VT = 45056, SL_CB = 56576, SL_CH = 78336, SL_ROW = 80896;
template <bool ML, bool PASSC>
__device__ __forceinline__ void scan_item(const Params& p, LAS unsigned char* L, const int qid, const int h, const int sl, const int g) {
    constexpr int NVT = ML ? 5 : 4, NT = ML ? 3 : 2;
    constexpr int NG = PASSC ? 2 : 4, TG = 512 / NG;
    constexpr int NLQ = 1024 / TG, NLW = 512 / TG, NLK = 1024 / TG, NLV = 512 / TG;
    const int tid = threadIdx.x, lane = tid & 63, wave = __builtin_amdgcn_readfirstlane(tid >> 6), fr = lane & 15, fq = lane >> 4;
    const int br = ML ? 0 : 1; const int item = qid * 4 + sl;
    const int gi = wave / (8 / NG), gt = tid & (TG - 1);
    unsigned char* ws = p.ws;
    const bf16_t* AQ = (const bf16_t*)(ws + WS_AQ); const bf16_t* KU = (const bf16_t*)(ws + WS_KU); const bf16_t* WW = (const bf16_t*)((const unsigned char*)p.out + OUT_WW);
    const bf16_t* V = (const bf16_t*)(ws + WS_R2); bf16_t* H = (bf16_t*)(ws + WS_R1); float* HSS = (float*)(ws + WS_HSS);
    const float* CHB = (const float*)(ws + WS_CHB); const float* CHM = (const float*)(ws + WS_CHM); const float* CHG = (const float*)(ws + WS_CHG); const float* BT = (const float*)(ws + WS_BT);
    f32x4* SEG = (f32x4*)(ws + WS_SEG);
    LAS bf16_t* sAq = (LAS bf16_t*)(L + SL_AQ); LAS bf16_t* sW = (LAS bf16_t*)(L + SL_W); LAS bf16_t* sKt = (LAS bf16_t*)(L + SL_KT);
    LAS bf16_t* sVt = (LAS bf16_t*)(L + SL_VT); LAS bf16_t* sCb = (LAS bf16_t*)(L + SL_CB); LAS float* sCH = (LAS float*)(L + SL_CH); LAS float* sRow = (LAS float*)(L + SL_ROW);
    const int cs = seg_start_b(ML, g), ce = seg_start_b(ML, g + 1);
    const int dt = wave, jt = wave & 3, vh = wave >> 2;

    u32x4 rq[NLQ], rw[NLW], rk[NLK], rv[NLV]; float rs = 0.f;
#define SCAN_LOAD(c) do { const int _t0 = (c) * 64; const int _ix = (c) * 8 + br * 4 + h; \
        if (PASSC) { _Pragma("unroll") for (int _i = 0; _i < NLQ; ++_i) { const int _p = gt + TG * _i; rq[_i] = *(const u32x4*)(AQ + (size_t)(_t0 + (_p >> 4)) * 1024 + br * 512 + h * 128 + (_p & 15) * 8); } \
            _Pragma("unroll") for (int _i = 0; _i < NLW; ++_i) rw[_i] = *(const u32x4*)(WW + (size_t)_ix * 4096 + (gt + TG * _i) * 8); } \
        _Pragma("unroll") for (int _i = 0; _i < NLK; ++_i) rk[_i] = *(const u32x4*)(KU + (size_t)_ix * 8192 + (gt + TG * _i) * 8); \
        _Pragma("unroll") for (int _i = 0; _i < NLV; ++_i) { const int _p = gt + TG * _i, _l = _p & 63, _pc = _p >> 6; \
            rv[_i] = (_t0 + _l >= 48) ? *(const u32x4*)(V + (size_t)(_t0 + _l) * 2048 + br * 1024 + h * 256 + sl * 64 + _pc * 8) : (u32x4){0u, 0u, 0u, 0u}; } \
        if (gt < 128) { if (ML) { if (PASSC) rs = (gt < 64) ? CHB[((c) * 4 + h) * 64 + gt] : CHM[((c) * 4 + h) * 64 + gt - 64]; } \
        else rs = BT[(size_t)((c) * 4 + h) * 128 + gt]; } } while (0)
#define SCAN_WRITE() do { \
        if (PASSC) { _Pragma("unroll") for (int _i = 0; _i < NLQ; ++_i) { const int _p = gt + TG * _i; *(LAS u32x4*)(sAq + (_p >> 4) * 136 + (_p & 15) * 8) = rq[_i]; } \
            _Pragma("unroll") for (int _i = 0; _i < NLW; ++_i) { const int _p = gt + TG * _i; *(LAS u32x4*)(sW + (_p >> 3) * 72 + (_p & 7) * 8) = rw[_i]; } } \
        _Pragma("unroll") for (int _i = 0; _i < NLK; ++_i) { const int _p = gt + TG * _i; *(LAS u32x4*)(sKt + (_p >> 3) * 72 + (_p & 7) * 8) = rk[_i]; } \
        _Pragma("unroll") for (int _i = 0; _i < NLV; ++_i) { const int _p = gt + TG * _i, _l = _p & 63, _pc = _p >> 6; \
            _Pragma("unroll") for (int _e = 0; _e < 4; ++_e) { const unsigned _wv = rv[_i][_e]; sVt[(_pc * 8 + 2 * _e) * 72 + _l] = (bf16_t)(_wv & 0xffffu); sVt[(_pc * 8 + 2 * _e + 1) * 72 + _l] = (bf16_t)(_wv >> 16); } } \
        if ((!ML || PASSC) && gt < 128) sRow[gt] = rs; } while (0)
#pragma unroll
    for (int k = 0; k < NG; ++k) { if (gi == k && cs + k < ce) SCAN_LOAD(cs + k); }

    if (ML) { if (tid < 128) { const int row = 64 + (tid >> 3), sg = tid & 7; const unsigned one = (row == 64) ? 0x3F803F80u : 0u; *(LAS u32x4*)(sVt + row * 72 + sg * 8) = (u32x4){one, one, one, one}; }
        for (int i = tid; i < NCH * 2; i += 512) sCH[i] = CHG[(i >> 1) * 8 + h * 2 + (i & 1)]; }
    LDS_BARRIER();

    f32x4 st[NVT];
#pragma unroll
    for (int vt = 0; vt < NVT; ++vt) st[vt] = (f32x4){0.f, 0.f, 0.f, 0.f};
    float mrun = 0.f; f32x4 btacc = (f32x4){0.f, 0.f, 0.f, 0.f};
    for (int gp = 0; gp < g; ++gp) {
        const int c0 = seg_start_b(ML, gp), c1 = seg_start_b(ML, gp + 1);
        f32x4 F;
        if (ML) { float Fl = 0.f;
#pragma unroll 8
            for (int c = c0; c < c1; ++c) { const float gc = sCH[2 * c], Ml = sCH[2 * c + 1]; const float mn = fmaxf(gc + mrun, Ml); Fl += gc + mrun - mn; mrun = mn; }
            const float f = __expf(Fl); F = (f32x4){f, f, f, f}; }
        else { f32x4 s4 = (f32x4){0.f, 0.f, 0.f, 0.f}; if (PASSC) s4 = *(const f32x4*)((const float*)(ws + WS_SEGBT) + (size_t)(h * 8 + gp) * 128 + dt * 16 + fq * 4);
            F = (f32x4){__expf(s4[0]), __expf(s4[1]), __expf(s4[2]), __expf(s4[3])}; }
        if (PASSC) { const int it2 = (qid - g + gp) * 4 + sl;
#pragma unroll
            for (int vt = 0; vt < NVT; ++vt) { const f32x4 Lv = SEG[((size_t)(it2 * 8 + dt) * 5 + vt) * 64 + lane]; st[vt] = F * st[vt] + Lv; } }
    }
    if (PASSC) {
#pragma unroll
        for (int vt = 0; vt < NVT; ++vt) { u32x2 w; w.x = cvt_pk_bf16(st[vt][0], st[vt][1]); w.y = cvt_pk_bf16(st[vt][2], st[vt][3]); *(LAS u32x2*)(sCb + (vt * 16 + fr) * 136 + dt * 16 + fq * 4) = w; }
    }

    for (int c = cs; c < ce; ++c) {
        if (gi == ((c - cs) & (NG - 1))) { SCAN_WRITE(); if (c + NG < ce) SCAN_LOAD(c + NG); }
        LDS_BARRIER();
        float a_c = 1.f, u_c = 1.f, a_int = 1.f, r_int = 1.f, clampv = 1.f; f32x4 dec = (f32x4){1.f, 1.f, 1.f, 1.f};
        if (ML) { const float gc = sCH[2 * c], Ml = sCH[2 * c + 1]; const float mn = fmaxf(gc + mrun, Ml); a_c = __expf(gc + mrun - mn); u_c = __expf(Ml - mn);
            if (PASSC && c > 0) { const float bj = sRow[jt * 16 + fr], mr = sRow[64 + jt * 16 + fr]; const float mrow = fmaxf(bj + mrun, mr);
                a_int = __expf(bj + mrun - mrow); r_int = __expf(mr - mrow); clampv = __expf(-mrow); }
            mrun = mn; }
        else { const f32x4 b4 = *(const LAS f32x4*)(sRow + dt * 16 + fq * 4); dec = (f32x4){__expf(b4[0]), __expf(b4[1]), __expf(b4[2]), __expf(b4[3])}; btacc += b4; }
        if (PASSC && c > 0) {
            f32x4 ai[NT], ae[NT];
#pragma unroll
            for (int q = 0; q < NT; ++q) { ai[q] = (f32x4){0.f, 0.f, 0.f, 0.f}; ae[q] = (f32x4){0.f, 0.f, 0.f, 0.f}; }
#pragma unroll
            for (int ks = 0; ks < 2; ++ks) { const bf16x8 wf = *(const LAS bf16x8*)(sW + (jt * 16 + fr) * 72 + ks * 32 + fq * 8);
#pragma unroll
                for (int q = 0; q < NT; ++q) { const int vt = q < 2 ? 2 * vh + q : 4; const bf16x8 vf = *(const LAS bf16x8*)(sVt + (vt * 16 + fr) * 72 + ks * 32 + fq * 8); ai[q] = MFMA16(vf, wf, ai[q]); } }
#pragma unroll
            for (int ks = 0; ks < 4; ++ks) { const bf16x8 af = *(const LAS bf16x8*)(sAq + (jt * 16 + fr) * 136 + ks * 32 + fq * 8);
#pragma unroll
                for (int q = 0; q < NT; ++q) { const int vt = q < 2 ? 2 * vh + q : 4; const bf16x8 cf = *(const LAS bf16x8*)(sCb + (vt * 16 + fr) * 136 + ks * 32 + fq * 8); ae[q] = MFMA16(cf, af, ae[q]); } }
            float dn = 1.f;
            if (ML) { const float denv = a_int * ae[NT - 1][0] + r_int * ai[NT - 1][0]; const float den = __shfl(denv, fr); dn = __builtin_amdgcn_rcpf(fmaxf(fabsf(den), clampv)); }
            const int row = (c - 1) * 64 + jt * 16 + fr; float ss = 0.f;
#pragma unroll
            for (int q = 0; q < 2; ++q) { f32x4 hv;
#pragma unroll
                for (int i = 0; i < 4; ++i) { hv[i] = ML ? (a_int * ae[q][i] + r_int * ai[q][i]) * dn : (ae[q][i] + ai[q][i]); ss += hv[i] * hv[i]; }
                u32x2 w; w.x = cvt_pk_bf16(hv[0], hv[1]); w.y = cvt_pk_bf16(hv[2], hv[3]);
                *(u32x2*)(H + (size_t)row * 2048 + br * 1024 + h * 256 + sl * 64 + (2 * vh + q) * 16 + fq * 4) = w; }
            ss += __shfl_xor(ss, 16); ss += __shfl_xor(ss, 32);
            if (fq == 0) HSS[(size_t)row * 64 + br * 32 + h * 8 + sl * 2 + vh] = ss;
        }
        f32x4 dl[NVT];
#pragma unroll
        for (int vt = 0; vt < NVT; ++vt) dl[vt] = (f32x4){0.f, 0.f, 0.f, 0.f};
#pragma unroll
        for (int ks = 0; ks < 2; ++ks) { const bf16x8 kf = *(const LAS bf16x8*)(sKt + (dt * 16 + fr) * 72 + ks * 32 + fq * 8);
#pragma unroll
            for (int vt = 0; vt < NVT; ++vt) { const bf16x8 vf = *(const LAS bf16x8*)(sVt + (vt * 16 + fr) * 72 + ks * 32 + fq * 8); dl[vt] = MFMA16(kf, vf, dl[vt]); } }
        LDS_BARRIER();
#pragma unroll
        for (int vt = 0; vt < NVT; ++vt) { if (ML) st[vt] = st[vt] * a_c + dl[vt] * u_c; else st[vt] = st[vt] * dec + dl[vt];
            if (PASSC) { u32x2 w; w.x = cvt_pk_bf16(st[vt][0], st[vt][1]); w.y = cvt_pk_bf16(st[vt][2], st[vt][3]); *(LAS u32x2*)(sCb + (vt * 16 + fr) * 136 + dt * 16 + fq * 4) = w; } }
    }
#undef SCAN_LOAD
#undef SCAN_WRITE
    if (!PASSC) {
#pragma unroll
        for (int vt = 0; vt < NVT; ++vt) SEG[((size_t)(item * 8 + dt) * 5 + vt) * 64 + lane] = st[vt];
        if (!ML && sl == 0 && fr == 0) *(f32x4*)((float*)(ws + WS_SEGBT) + (size_t)(h * 8 + g) * 128 + dt * 16 + fq * 4) = btacc;
    }
    LDS_BARRIER();
}

__device__ __forceinline__ void scan_phase(const Params& p, LAS unsigned char* L, const bool passC) {
    for (int b = blockIdx.x; b < 256; b += gridDim.x) {
        const int x = b & 7, y = b >> 3, qid = x + 8 * (y >> 2), sl = y & 3;
        const bool ml = qid < 4 * NSEG_M;
        const int qq = ml ? qid : qid - 4 * NSEG_M, ns = ml ? NSEG_M : NSEG_G, h = qq / ns, g = qq - h * ns;
        if (!passC && g == ns - 1) continue;
        if (passC) { if (ml) scan_item<true, true>(p, L, qid, h, sl, g); else scan_item<false, true>(p, L, qid, h, sl, g); }
        else { if (ml) scan_item<true, false>(p, L, qid, h, sl, g); else scan_item<false, false>(p, L, qid, h, sl, g); }
    }
}

__global__ void __launch_bounds__(512, 2) fwd_megakernel(Params p) {
    extern __shared__ __attribute__((aligned(16))) unsigned char lds_raw[];
    LAS unsigned char* L = (LAS unsigned char*)lds_raw;
    cg::grid_group grid = cg::this_grid();
    const int lo = p.ph_lo, hi = p.ph_hi, G = gridDim.x;
    unsigned char* ws = p.ws;
#define IN(k) (lo <= (k) && (k) < hi)
#define SEAM(k) do { if (IN(k) && IN((k) + 1)) xcd_barrier(bar); } while (0)
    if (lo < 0) grid.sync();
    if (threadIdx.x < 16) ((LAS unsigned*)(L + MISC_OFF))[threadIdx.x] = 0u;
    __syncthreads();
    XcdBarrier bar = xcd_barrier_post((unsigned*)(ws + WS_BAR), (volatile LAS unsigned*)(L + MISC_OFF));
    if (IN(0)) p0_prologue(p, L);
    SEAM(0);
    if (IN(1)) { pg8::Gemm g{(const bf16_t*)((const unsigned char*)p.out + OUT_XN), (const bf16_t*)(ws + WS_WTA), SEQ, 4096, 1024, 1024, 0, 0};
        pg8::StaticOrder S; S.init(SEQ, 4096, G, (int)blockIdx.x);
        pg8::EpiQKV E{(bf16_t*)(ws + WS_R1), (bf16_t*)(ws + WS_R2)};
        pg8::gemm_phase<pg8::EpiQKV, pg8::StaticOrder>(L, g, S, E); }
    SEAM(1);
    if (IN(2)) x_phase<false>(p, L, (int)blockIdx.x, (G == 256 ? (NCH - 1) * 8 : NCH * 8), G);
    SEAM(2);
    if (IN(3)) {
        if (G == 256) { const int b = blockIdx.x, x = b & 7, y = b >> 3, qid = x + 8 * (y >> 2), sl = y & 3; const bool ml = qid < 4 * NSEG_M;
            const int qq = ml ? qid : qid - 4 * NSEG_M, ns = ml ? NSEG_M : NSEG_G, hh = qq / ns, gg = qq - hh * ns;
            if (gg == ns - 1 && sl == 0) { const int it = (NCH - 1) * 8 + (ml ? 0 : 4) + hh; x_phase<true>(p, L, it, it + 1, 256); } }
        scan_phase(p, L, false);
    }
    SEAM(3);
    if (IN(4)) scan_phase(p, L, true);
    SEAM(4);
    if (IN(5)) { pg8::Gemm g{(const bf16_t*)((const unsigned char*)p.out + OUT_XN), (const bf16_t*)(ws + WS_WTB), SEQ, 4096, 1024, 1024, 0, 0};
        pg8::StaticOrder S; S.init(SEQ, 4096, G, (int)blockIdx.x);
        pg8::EpiGate E{(bf16_t*)(ws + WS_R1), (bf16_t*)(ws + WS_R2), (const float*)(ws + WS_HSS), p.in[9], p.in[10]};
        pg8::gemm_phase<pg8::EpiGate, pg8::StaticOrder>(L, g, S, E); }
    SEAM(5);
    if (IN(6)) { pg8::Gemm g{(const bf16_t*)(ws + WS_R1), (const bf16_t*)(ws + WS_WTBM), SEQ, 1024, 1024, 2048, (size_t)1024 * 2, (size_t)2 * MiB};
        pg8::TwoPassOrder S; S.init(SEQ, 1024, G, (int)blockIdx.x);
        pg8::EpiMerge E{(bf16_t*)(ws + WS_AQ), (const bf16_t*)(ws + WS_R2)};
        pg8::gemm_phase<pg8::EpiMerge, pg8::TwoPassOrder>(L, g, S, E); }
    SEAM(6);
    if (IN(7)) { pg8::Gemm g{(const bf16_t*)(ws + WS_AQ), (const bf16_t*)(ws + WS_WTO), SEQ, 1024, 1024, 1024, 0, 0};
        pg8::StaticOrder S; S.init(SEQ, 1024, G, (int)blockIdx.x);
        pg8::EpiResid E{p.in[0], (bf16_t*)(ws + WS_KU), (float*)(ws + WS_SS1)};
        pg8::gemm_phase<pg8::EpiResid, pg8::StaticOrder>(L, g, S, E); }
    SEAM(7);
    if (IN(8)) { pg8::Gemm g{(const bf16_t*)(ws + WS_KU), (const bf16_t*)(ws + WS_WTFF), SEQ, 2 * DFF, 1024, 1024, 0, 0};
        pg8::StaticOrder S; S.init(SEQ, 2 * DFF, G, (int)blockIdx.x);
        pg8::EpiFF E{(bf16_t*)(ws + WS_FF), (const float*)(ws + WS_SS1)};
        pg8::gemm_phase<pg8::EpiFF, pg8::StaticOrder>(L, g, S, E); }
    SEAM(8);
    if (IN(9)) { pg8::Gemm g{(const bf16_t*)(ws + WS_FF), (const bf16_t*)(ws + WS_WTD), SEQ, 1024, DFF, DFF, 0, 0};
        pg8::StaticOrder S; S.init(SEQ, 1024, G, (int)blockIdx.x);
        pg8::EpiFinal E{p.out, (const bf16_t*)(ws + WS_KU), p.in[18], (float*)(ws + WS_SS2), (unsigned*)(ws + WS_PCNT)};
        pg8::gemm_phase<pg8::EpiFinal, pg8::StaticOrder>(L, g, S, E); }
#undef IN
#undef SEAM
}

extern "C" void kernel_launch(void* const* d_in, const int* in_sizes, int n_in, void* d_out, int out_size, void* d_ws, size_t ws_size, hipStream_t stream) {
    static int grid = 0;
    if (grid == 0) {
        if (n_in != 19 || out_size != SEQ * DM || ws_size < WS_END) { fprintf(stderr, "kernel_launch: unexpected sizes (n_in %d out %d ws %zu)\n", n_in, out_size, ws_size); grid = -1; return; }
        int dev = 0, cus = 0, per_cu = 0;
        (void)hipGetDevice(&dev); (void)hipDeviceGetAttribute(&cus, hipDeviceAttributeMultiprocessorCount, dev);
        if (hipFuncSetAttribute((const void*)fwd_megakernel, hipFuncAttributeMaxDynamicSharedMemorySize, LDS_BYTES) != hipSuccess) { fprintf(stderr, "kernel_launch: hipFuncSetAttribute failed\n"); grid = -1; return; }
        if (hipOccupancyMaxActiveBlocksPerMultiprocessor(&per_cu, (const void*)fwd_megakernel, 512, LDS_BYTES) != hipSuccess || per_cu < 1) { fprintf(stderr, "kernel_launch: occupancy query says %d\n", per_cu); per_cu = 1; }
        (void)hipGetLastError();
        grid = cus * 1;
        if (grid <= 0) grid = 256;
    }
    if (grid < 0) return;
    if (hipMemsetAsync(d_ws, 0, CTL_ZERO_BYTES, stream) != hipSuccess) { fprintf(stderr, "kernel_launch: memset failed\n"); return; }
    Params a{};
    for (int i = 0; i < 19; ++i) a.in[i] = (const float*)d_in[i];
    a.out = (float*)d_out; a.ws = (unsigned char*)d_ws;
#if N_LAUNCH_MODE == 1
    a.ph_lo = 0; a.ph_hi = 10;
    void* args[] = {&a};
    hipError_t e = hipLaunchCooperativeKernel((const void*)fwd_megakernel, dim3(grid), dim3(512), args, LDS_BYTES, stream);
    if (e != hipSuccess) fprintf(stderr, "cooperative launch failed: %s (grid %d)\n", hipGetErrorString(e), grid);
#else
    for (int ph = 0; ph < 10; ++ph) { a.ph_lo = ph; a.ph_hi = ph + 1;
        hipLaunchKernelGGL(fwd_megakernel, dim3(grid), dim3(512), LDS_BYTES, stream, a); }
#endif
}
```

```cpp
#include <hip/hip_runtime.h>
#include <hip/hip_cooperative_groups.h>
#include <cstdio>
#include <cstdint>
namespace cg = cooperative_groups;

#define LAS __attribute__((address_space(3)))
typedef unsigned short bf16_t;
typedef short bf16x8 __attribute__((ext_vector_type(8)));
typedef float f32x4 __attribute__((ext_vector_type(4)));
typedef unsigned u32x4 __attribute__((ext_vector_type(4)));
typedef unsigned u32x2 __attribute__((ext_vector_type(2)));

#ifndef N_LAUNCH_MODE
#define N_LAUNCH_MODE 1
#endif

constexpr int DM = 1024, SEQ = 16384, TP = SEQ + 64, NCH = 257, NPROJ = 8216, DFF = 2816;
constexpr float EPS = 1e-6f;
constexpr float QSCALE = 0.08838834764831845f;
constexpr int NSEG_M = 9, NSEG_G = 7;
__host__ __device__ constexpr int seg_start_b(bool ml, int g) { return ml ? (g * 257 + 4) / 9 : (g * 257 + 3) / 7; }

constexpr size_t MiB = 1u << 20;
constexpr size_t WS_SS1 = 0, WS_SS2 = 65536, WS_BAR = 131072, WS_PCNT = 147456, CTL_ZERO_BYTES = 163840;
constexpr size_t WS_GI = 1 * MiB, WS_GF = 1 * MiB + 512 * 1024, WS_GA = 2 * MiB;
constexpr size_t WS_HSS = 4 * MiB;
constexpr size_t WS_CHB = 8 * MiB, WS_CHM = 8 * MiB + 512 * 1024, WS_CHG = 9 * MiB, WS_BT = 9 * MiB + 65536, WS_SEGBT = 9 * MiB + 768 * 1024;
constexpr size_t WS_WTA = 10 * MiB, WS_WTB = 18 * MiB, WS_WTBM = 26 * MiB, WS_WTO = 30 * MiB, WS_WTFF = 32 * MiB, WS_WTD = 43 * MiB;
constexpr size_t WS_R1 = 49 * MiB;
constexpr size_t WS_R2 = 114 * MiB;
constexpr size_t WS_AQ = 179 * MiB;
constexpr size_t WS_KU = 212 * MiB;
constexpr size_t WS_SEG = 245 * MiB;
constexpr size_t WS_FF = WS_R1;
constexpr size_t WS_END = 256 * MiB;
constexpr size_t OUT_XN = 0, OUT_WW = 32 * MiB;

constexpr int LDS_BYTES = 147456, MISC_OFF = 146432;

typedef float f32x2_t __attribute__((ext_vector_type(2)));
typedef __bf16 bf16x2_t __attribute__((ext_vector_type(2)));
__device__ __forceinline__ unsigned cvt_pk_bf16(float lo, float hi) { const f32x2_t v = {lo, hi}; const bf16x2_t b = __builtin_convertvector(v, bf16x2_t); return __builtin_bit_cast(unsigned, b); }
__device__ __forceinline__ float bf_lo(unsigned u) { return __uint_as_float(u << 16); }
__device__ __forceinline__ float bf_hi(unsigned u) { return __uint_as_float(u & 0xffff0000u); }
__device__ __forceinline__ float bf2f(bf16_t b) { return __uint_as_float(((unsigned)b) << 16); }
__device__ __forceinline__ bf16_t f2bf(float f) { return (bf16_t)(cvt_pk_bf16(f, 0.f) & 0xffffu); }
#define DPP_F(old, src, ctrl, rmask, bc) __int_as_float(__builtin_amdgcn_update_dpp(__float_as_int(old), __float_as_int(src), (ctrl), (rmask), 0xf, (bc)))
__device__ __forceinline__ float wave_sum(float v) {
    v += DPP_F(0.f, v, 0xB1, 0xf, true);
    v += DPP_F(0.f, v, 0x4E, 0xf, true);
    v += DPP_F(0.f, v, 0x141, 0xf, true);
    v += DPP_F(0.f, v, 0x140, 0xf, true);
    v += DPP_F(0.f, v, 0x142, 0xa, false);
    v += DPP_F(0.f, v, 0x143, 0xc, false);
    return __int_as_float(__builtin_amdgcn_readlane(__float_as_int(v), 63));
}
__device__ __forceinline__ float wave_max(float v) {
    v = fmaxf(v, DPP_F(v, v, 0xB1, 0xf, false));
    v = fmaxf(v, DPP_F(v, v, 0x4E, 0xf, false));
    v = fmaxf(v, DPP_F(v, v, 0x141, 0xf, false));
    v = fmaxf(v, DPP_F(v, v, 0x140, 0xf, false));
    v = fmaxf(v, DPP_F(v, v, 0x142, 0xa, false));
    v = fmaxf(v, DPP_F(v, v, 0x143, 0xc, false));
    return __int_as_float(__builtin_amdgcn_readlane(__float_as_int(v), 63));
}
__device__ __forceinline__ float wave_scan_sum(float v) {
    v += DPP_F(0.f, v, 0x111, 0xf, true); v += DPP_F(0.f, v, 0x112, 0xf, true); v += DPP_F(0.f, v, 0x114, 0xf, true); v += DPP_F(0.f, v, 0x118, 0xf, true);
    v += DPP_F(0.f, v, 0x142, 0xa, false); v += DPP_F(0.f, v, 0x143, 0xc, false);
    return v;
}
__device__ __forceinline__ float wave_scan_max(float v) {
    v = fmaxf(v, DPP_F(v, v, 0x111, 0xf, false)); v = fmaxf(v, DPP_F(v, v, 0x112, 0xf, false)); v = fmaxf(v, DPP_F(v, v, 0x114, 0xf, false)); v = fmaxf(v, DPP_F(v, v, 0x118, 0xf, false));
    v = fmaxf(v, DPP_F(v, v, 0x142, 0xa, false)); v = fmaxf(v, DPP_F(v, v, 0x143, 0xc, false));
    return v;
}
__device__ __forceinline__ float sigmoidf_(float x) { return __builtin_amdgcn_rcpf(1.f + __expf(-x)); }
__device__ __forceinline__ float siluf_(float x) { return x * __builtin_amdgcn_rcpf(1.f + __expf(-x)); }
__device__ __forceinline__ float logsigmoidf_(float z) { return fminf(z, 0.f) - __logf(1.f + __expf(-fabsf(z))); }
#define LDS_BARRIER() do { asm volatile("s_waitcnt lgkmcnt(0)" ::: "memory"); __builtin_amdgcn_s_barrier(); asm volatile("" ::: "memory"); } while (0)
#define MFMA16(a, b, c) __builtin_amdgcn_mfma_f32_16x16x32_bf16((a), (b), (c), 0, 0, 0)

namespace pg8 {
constexpr int BM = 256, BK = 64, HALF = 128, HTB = HALF * BK * 2, NXCD = 8, WGM = 1;
__host__ __device__ __forceinline__ int lds_byte(int r, int c) { const int st = (r >> 4) * 2 + (c >> 5), rr = r & 15, cc = c & 31, ob = rr * 64 + cc * 2; return st * 1024 + (ob ^ (((ob >> 9) & 1) << 5)); }
__host__ __device__ __forceinline__ void stage_rc(int b, int& R, int& C) { const int st = b / 1024, sb = b % 1024, swz = sb ^ (((sb >> 9) & 1) << 5); R = (st >> 1) * 16 + swz / 64; C = (st & 1) * 32 + (swz % 64) / 2; }
__host__ __device__ __forceinline__ int perm32(int rho) { const int n = rho >> 4, i = rho & 15; return 8 * (i >> 2) + 4 * n + (i & 3); }

struct Unit { int pm, pn, ks; };
struct Gemm { const bf16_t* A; const bf16_t* Bt; int M, N, K, lda; size_t ksA, ksB; };

struct StaticOrder {
    int nM, nN, nwg, G, c;
    __device__ void init(int M, int N, int G_, int c_) { nM = M / BM; nN = N / BM; nwg = nM * nN; G = G_; c = c_; }
    __device__ bool next(int i, Unit& u) const {
        const long Lx = (long)i * G + c; if (Lx >= nwg) return false;
        int wgid = (int)Lx; { const int q = nwg / NXCD, r = nwg % NXCD, xcd = wgid % NXCD, off = wgid / NXCD; wgid = (xcd < r ? xcd * (q + 1) : r * (q + 1) + (xcd - r) * q) + off; }
        const int nig = WGM * nN, gid = wgid / nig, fm = gid * WGM, gsz = (nM - fm) < WGM ? (nM - fm) : WGM;
        u.pm = fm + ((wgid % nig) % gsz); u.pn = (wgid % nig) / gsz; u.ks = 0; return true;
    }
};
struct TwoPassOrder {
    int ntile, nN, G, c;
    __device__ void init(int M, int N, int G_, int c_) { nN = N / BM; ntile = (M / BM) * nN; G = G_; c = c_; }
    __device__ bool next(int i, Unit& u) const {
        const int cc = (G % 8 == 0) ? (c % 8) * (G / 8) + c / 8 : c;
        const int tl = (i >> 1) * G + cc; if (tl >= ntile) return false;
        u.pm = tl / nN; u.pn = tl % nN; u.ks = i & 1; return true;
    }
};

template <class Epi, class Sched>
__device__ __forceinline__ void gemm_phase(LAS unsigned char* lds, const Gemm g, const Sched& S, const Epi& E) {
    const int tid = threadIdx.x, wid = __builtin_amdgcn_readfirstlane(tid >> 6), lane = tid & 63, wr = wid >> 2, wc = wid & 3, fr = lane & 15, fq = lane >> 4;
    const int K = g.K, nt = K / BK;
    unsigned voffA[2], voffB[2];
#pragma unroll
    for (int i = 0; i < 2; ++i) { int R, C; stage_rc(tid * 16 + i * 8192, R, C); const int Rb = (R & ~31) + perm32(R & 31);
        voffA[i] = (unsigned)(R * g.lda + C) * 2u; voffB[i] = (unsigned)(Rb * K + C) * 2u; }
    const size_t kstep = (size_t)(BK * 2);
    const size_t hstepA = (size_t)HALF * g.lda * 2, hstepB = (size_t)HALF * K * 2;
    const size_t tstepA = 2 * hstepA, tstepB = 2 * hstepB;
    const unsigned ldsw = (unsigned)wid * 1024u;
    const int aoff = lds_byte(wr * 64 + fr, fq * 8), boff = lds_byte(wc * 32 + fr, fq * 8);
#define PG8_SA(b, h) (((b) * 2 + (h)) * HTB)
#define PG8_SB(b, h) ((4 + (b) * 2 + (h)) * HTB)
#define PG8_STAGE(bufoff, gbase, voff) do { _Pragma("unroll") for (int _i = 0; _i < 2; ++_i) \
        __builtin_amdgcn_global_load_lds((const unsigned*)((const char*)(gbase) + (voff)[_i]), (LAS unsigned*)(lds + (bufoff) + ldsw + _i * 8192), 16, 0, 0); } while (0)
#define PG8_LDA(dst, b, h) do { _Pragma("unroll") for (int m = 0; m < 4; ++m) _Pragma("unroll") for (int k = 0; k < 2; ++k) dst[m][k] = *(const LAS bf16x8*)(lds + PG8_SA(b, h) + aoff + m * 2048 + k * 1024); } while (0)
#define PG8_LDB(dst, b, h) do { _Pragma("unroll") for (int n = 0; n < 2; ++n) _Pragma("unroll") for (int k = 0; k < 2; ++k) dst[n][k] = *(const LAS bf16x8*)(lds + PG8_SB(b, h) + boff + n * 2048 + k * 1024); } while (0)
#define PG8_MMA(ai, bj, At, Bt) do { __builtin_amdgcn_s_setprio(1); _Pragma("unroll") for (int m = 0; m < 4; ++m) _Pragma("unroll") for (int n = 0; n < 2; ++n) _Pragma("unroll") for (int k = 0; k < 2; ++k) \
        acc[ai][bj][m][n] = __builtin_amdgcn_mfma_f32_16x16x32_bf16(Bt[n][k], At[m][k], acc[ai][bj][m][n], 0, 0, 0); __builtin_amdgcn_s_setprio(0); } while (0)
#define PG8_WAIT_V(n) asm volatile("s_waitcnt vmcnt(" #n ")" ::: "memory")
#define PG8_WAIT_L(n) asm volatile("s_waitcnt lgkmcnt(" #n ")" ::: "memory")
#define PG8_BAR __builtin_amdgcn_s_barrier()
#define PG8_SCHED __builtin_amdgcn_sched_barrier(0)
    Unit cur, nxt; int ui = 0;
    if (!S.next(0, cur)) return;
    f32x4 acc[2][2][4][2];
#pragma unroll
    for (int a = 0; a < 2; ++a)
#pragma unroll
        for (int b = 0; b < 2; ++b)
#pragma unroll
            for (int m = 0; m < 4; ++m)
#pragma unroll
                for (int n = 0; n < 2; ++n) acc[a][b][m][n] = (f32x4){0.f, 0.f, 0.f, 0.f};
    bf16x8 At[4][2], B0[2][2], B1[2][2];
    const char* cA = (const char*)g.A + (size_t)cur.pm * tstepA + (size_t)cur.ks * g.ksA; const char* cB = (const char*)g.Bt + (size_t)cur.pn * tstepB + (size_t)cur.ks * g.ksB;
    PG8_STAGE(PG8_SB(0, 0), cB, voffB); PG8_STAGE(PG8_SB(0, 1), cB + hstepB, voffB); PG8_STAGE(PG8_SA(0, 0), cA, voffA); PG8_STAGE(PG8_SA(0, 1), cA + hstepA, voffA);
    if (wr == 1) PG8_BAR;
    PG8_WAIT_V(2); PG8_BAR;
    PG8_STAGE(PG8_SB(1, 0), cB + kstep, voffB); PG8_STAGE(PG8_SA(1, 0), cA + kstep, voffA); PG8_STAGE(PG8_SB(1, 1), cB + hstepB + kstep, voffB);
    PG8_WAIT_V(6); PG8_BAR;
    for (;;) {
        const bool has_next = S.next(ui + 1, nxt);
        const char* nA = has_next ? (const char*)g.A + (size_t)nxt.pm * tstepA + (size_t)nxt.ks * g.ksA : cA; const char* nB = has_next ? (const char*)g.Bt + (size_t)nxt.pn * tstepB + (size_t)nxt.ks * g.ksB : cB;
        for (int t = 0; t < nt; t += 2) {
            const bool last = (t == nt - 2);
            const char* a1 = cA + (size_t)(t + 1) * kstep;
            const char* a2 = last ? nA : cA + (size_t)(t + 2) * kstep; const char* b2 = last ? nB : cB + (size_t)(t + 2) * kstep;
            const char* a3 = a2 + kstep; const char* b3 = b2 + kstep;
            PG8_LDB(B0, 0, 0); PG8_LDB(B1, 0, 1); PG8_SCHED; PG8_LDA(At, 0, 0); PG8_STAGE(PG8_SA(1, 1), a1 + hstepA, voffA);
            PG8_WAIT_V(8); PG8_WAIT_L(0); PG8_BAR; PG8_MMA(0, 0, At, B0); PG8_MMA(0, 1, At, B1); PG8_BAR; PG8_SCHED;
            PG8_LDA(At, 0, 1); PG8_STAGE(PG8_SB(0, 0), b2, voffB); PG8_STAGE(PG8_SB(0, 1), b2 + hstepB, voffB); PG8_STAGE(PG8_SA(0, 0), a2, voffA);
            PG8_WAIT_V(8); PG8_WAIT_L(0); PG8_BAR; PG8_MMA(1, 0, At, B0); PG8_MMA(1, 1, At, B1); PG8_BAR; PG8_SCHED;
            PG8_LDB(B0, 1, 0); PG8_LDB(B1, 1, 1); PG8_SCHED; PG8_LDA(At, 1, 0); PG8_STAGE(PG8_SA(0, 1), a2 + hstepA, voffA);
            PG8_WAIT_V(8); PG8_WAIT_L(0); PG8_BAR; PG8_MMA(0, 0, At, B0); PG8_MMA(0, 1, At, B1); PG8_BAR; PG8_SCHED;
            PG8_LDA(At, 1, 1); PG8_STAGE(PG8_SB(1, 0), b3, voffB); PG8_STAGE(PG8_SB(1, 1), b3 + hstepB, voffB); PG8_STAGE(PG8_SA(1, 0), a3, voffA);
            PG8_WAIT_V(8); PG8_WAIT_L(0); PG8_BAR; PG8_MMA(1, 0, At, B0); PG8_MMA(1, 1, At, B1); PG8_BAR; PG8_SCHED;
        }
        if (wr == 0) PG8_BAR;
        E(acc, cur, wr, wc, fr, fq);
        if (!has_next) break;
#pragma unroll
        for (int a = 0; a < 2; ++a)
#pragma unroll
            for (int b = 0; b < 2; ++b)
#pragma unroll
                for (int m = 0; m < 4; ++m)
#pragma unroll
                    for (int n = 0; n < 2; ++n) acc[a][b][m][n] = (f32x4){0.f, 0.f, 0.f, 0.f};
        cur = nxt; cA = nA; cB = nB; ++ui;
        if (wr == 1) PG8_BAR;
    }
    PG8_WAIT_V(0);
    PG8_BAR;
#undef PG8_SA
#undef PG8_SB
#undef PG8_STAGE
#undef PG8_LDA
#undef PG8_LDB
#undef PG8_MMA
#undef PG8_WAIT_V
#undef PG8_WAIT_L
#undef PG8_BAR
#undef PG8_SCHED
}

__device__ __forceinline__ u32x4 pack8(const f32x4 v0, const f32x4 v1) { u32x4 w; w.x = cvt_pk_bf16(v0[0], v0[1]); w.y = cvt_pk_bf16(v0[2], v0[3]); w.z = cvt_pk_bf16(v1[0], v1[1]); w.w = cvt_pk_bf16(v1[2], v1[3]); return w; }
__device__ __forceinline__ void unpack8(const u32x4 w, f32x4& v0, f32x4& v1) { v0 = (f32x4){bf_lo(w.x), bf_hi(w.x), bf_lo(w.y), bf_hi(w.y)}; v1 = (f32x4){bf_lo(w.z), bf_hi(w.z), bf_lo(w.w), bf_hi(w.w)}; }

struct EpiQKV {
    bf16_t* rawqk; bf16_t* vbuf;
    __device__ __forceinline__ void operator()(const f32x4 (&acc)[2][2][4][2], const Unit& u, int wr, int wc, int fr, int fq) const {
        int colt = u.pn * BM; bf16_t* base = rawqk; if (colt >= 2048) { base = vbuf; colt -= 2048; }
        const int row0 = 64 + u.pm * BM + wr * 64 + fr, col0 = colt + wc * 32 + 8 * fq;
#pragma unroll
        for (int ai = 0; ai < 2; ++ai)
#pragma unroll
            for (int m = 0; m < 4; ++m) { bf16_t* rowp = base + (size_t)(row0 + ai * HALF + m * 16) * 2048 + col0;
#pragma unroll
                for (int bj = 0; bj < 2; ++bj) *(u32x4*)(rowp + bj * HALF) = pack8(acc[ai][bj][m][0], acc[ai][bj][m][1]); }
    }
};

struct EpiGate {
    bf16_t* H; bf16_t* G2; const float* hss; const float* mg; const float* gg;
    __device__ __forceinline__ void operator()(const f32x4 (&acc)[2][2][4][2], const Unit& u, int wr, int wc, int fr, int fq) const {
        const int row0 = u.pm * BM + wr * 64 + fr;
        if (u.pn >= 8) {
            const int col0 = (u.pn - 8) * BM + wc * 32 + 8 * fq;
#pragma unroll
            for (int ai = 0; ai < 2; ++ai)
#pragma unroll
                for (int m = 0; m < 4; ++m) { bf16_t* rowp = G2 + (size_t)(row0 + ai * HALF + m * 16) * 2048 + col0;
#pragma unroll
                    for (int bj = 0; bj < 2; ++bj) { f32x4 v0 = acc[ai][bj][m][0], v1 = acc[ai][bj][m][1];
#pragma unroll
                        for (int e = 0; e < 4; ++e) { v0[e] = sigmoidf_(v0[e]); v1[e] = sigmoidf_(v1[e]); }
                        *(u32x4*)(rowp + bj * HALF) = pack8(v0, v1); } }
        } else {
            const int br = u.pn >> 2, head = u.pn & 3;
            const float* gain = (br ? gg : mg) + head * 256 + wc * 32 + 8 * fq;
            f32x4 gv[2][2];
#pragma unroll
            for (int bj = 0; bj < 2; ++bj) { gv[bj][0] = *(const f32x4*)(gain + bj * HALF); gv[bj][1] = *(const f32x4*)(gain + bj * HALF + 4); }
            const int col0 = br * 1024 + head * 256 + wc * 32 + 8 * fq;
#pragma unroll
            for (int ai = 0; ai < 2; ++ai) {
                float rs4[4];
                {   f32x4 sa[4], sb[4];
#pragma unroll
                    for (int m = 0; m < 4; ++m) { const int row = row0 + ai * HALF + m * 16;
                        sa[m] = *(const f32x4*)(hss + (size_t)row * 64 + br * 32 + head * 8); sb[m] = *(const f32x4*)(hss + (size_t)row * 64 + br * 32 + head * 8 + 4); }
#pragma unroll
                    for (int m = 0; m < 4; ++m) { const f32x4 s0 = sa[m], s1 = sb[m];
                        const float ssum = ((s0[0] + s0[1]) + (s0[2] + s0[3])) + ((s1[0] + s1[1]) + (s1[2] + s1[3]));
                        rs4[m] = __builtin_amdgcn_rsqf(ssum * (1.f / 256.f) + EPS); } }
                u32x4 hraw[4][2];
#pragma unroll
                for (int m = 0; m < 4; ++m)
#pragma unroll
                    for (int bj = 0; bj < 2; ++bj) hraw[m][bj] = *(const u32x4*)(H + (size_t)(row0 + ai * HALF + m * 16) * 2048 + col0 + bj * HALF);
#pragma unroll
                for (int m = 0; m < 4; ++m) { const int row = row0 + ai * HALF + m * 16;
                    const float rstd = rs4[m];
                    bf16_t* rowp = H + (size_t)row * 2048 + col0;
#pragma unroll
                    for (int bj = 0; bj < 2; ++bj) { f32x4 a0 = acc[ai][bj][m][0], a1 = acc[ai][bj][m][1], h0, h1;
                        unpack8(hraw[m][bj], h0, h1);
#pragma unroll
                        for (int e = 0; e < 4; ++e) { const float g0 = br ? siluf_(a0[e]) : sigmoidf_(a0[e]), g1 = br ? siluf_(a1[e]) : sigmoidf_(a1[e]);
                            h0[e] = h0[e] * rstd * gv[bj][0][e] * g0; h1[e] = h1[e] * rstd * gv[bj][1][e] * g1; }
                        *(u32x4*)(rowp + bj * HALF) = pack8(h0, h1); } } }
        }
    }
};

struct EpiMerge {
    bf16_t* MG; const bf16_t* G2;
    __device__ __forceinline__ void operator()(const f32x4 (&acc)[2][2][4][2], const Unit& u, int wr, int wc, int fr, int fq) const {
        const int row0 = u.pm * BM + wr * 64 + fr, col0 = u.pn * BM + wc * 32 + 8 * fq;
#pragma unroll
        for (int ai = 0; ai < 2; ++ai) {
            u32x4 gr[4][2], pr[4][2];
#pragma unroll
            for (int m = 0; m < 4; ++m)
#pragma unroll
                for (int bj = 0; bj < 2; ++bj) { const int row = row0 + ai * HALF + m * 16;
                    gr[m][bj] = *(const u32x4*)(G2 + (size_t)row * 2048 + u.ks * 1024 + col0 + bj * HALF);
                    pr[m][bj] = u.ks ? *(const u32x4*)(MG + (size_t)row * 1024 + col0 + bj * HALF) : (u32x4){0u, 0u, 0u, 0u}; }
#pragma unroll
            for (int m = 0; m < 4; ++m) { const int row = row0 + ai * HALF + m * 16; bf16_t* rowp = MG + (size_t)row * 1024 + col0;
#pragma unroll
                for (int bj = 0; bj < 2; ++bj) { f32x4 g0, g1, p0, p1; unpack8(gr[m][bj], g0, g1); unpack8(pr[m][bj], p0, p1);
                    *(u32x4*)(rowp + bj * HALF) = pack8(acc[ai][bj][m][0] * g0 + p0, acc[ai][bj][m][1] * g1 + p1); } } }
    }
};

struct EpiResid {
    const float* resid; bf16_t* h1b; float* sumsq;
    __device__ __forceinline__ void operator()(const f32x4 (&acc)[2][2][4][2], const Unit& u, int wr, int wc, int fr, int fq) const {
        const int row0 = u.pm * BM + wr * 64 + fr, col0 = u.pn * BM + wc * 32 + 8 * fq;
#pragma unroll
        for (int ai = 0; ai < 2; ++ai) {
            f32x4 rv[4][2][2];
#pragma unroll
            for (int m = 0; m < 4; ++m)
#pragma unroll
                for (int bj = 0; bj < 2; ++bj) { const size_t o = (size_t)(row0 + ai * HALF + m * 16) * 1024 + col0 + bj * HALF; rv[m][bj][0] = *(const f32x4*)(resid + o); rv[m][bj][1] = *(const f32x4*)(resid + o + 4); }
#pragma unroll
            for (int m = 0; m < 4; ++m) { const int row = row0 + ai * HALF + m * 16; float ss = 0.f;
#pragma unroll
                for (int bj = 0; bj < 2; ++bj) { const size_t o = (size_t)row * 1024 + col0 + bj * HALF;
                    const f32x4 v0 = rv[m][bj][0] + acc[ai][bj][m][0], v1 = rv[m][bj][1] + acc[ai][bj][m][1];
                    ss += (v0[0] * v0[0] + v0[1] * v0[1]) + (v0[2] * v0[2] + v0[3] * v0[3]) + (v1[0] * v1[0] + v1[1] * v1[1]) + (v1[2] * v1[2] + v1[3] * v1[3]);
                    *(u32x4*)(h1b + o) = pack8(v0, v1); }
                ss += __shfl_xor(ss, 16); ss += __shfl_xor(ss, 32);
                if (fq == 0) __hip_atomic_fetch_add(sumsq + row, ss, __ATOMIC_RELAXED, __HIP_MEMORY_SCOPE_AGENT); } }
    }
};

struct EpiFF {
    bf16_t* FF; const float* sumsq;
    __device__ __forceinline__ void operator()(const f32x4 (&acc)[2][2][4][2], const Unit& u, int wr, int wc, int fr, int fq) const {
        const int row0 = u.pm * BM + wr * 64 + fr, col0 = u.pn * HALF + wc * 32 + 8 * fq;
        float ssq[2][4];
#pragma unroll
        for (int ai = 0; ai < 2; ++ai)
#pragma unroll
            for (int m = 0; m < 4; ++m) ssq[ai][m] = sumsq[row0 + ai * HALF + m * 16];
#pragma unroll
        for (int ai = 0; ai < 2; ++ai)
#pragma unroll
            for (int m = 0; m < 4; ++m) { const int row = row0 + ai * HALF + m * 16;
                const float r = __builtin_amdgcn_rsqf(ssq[ai][m] * (1.f / 1024.f) + EPS);
                f32x4 v0, v1;
#pragma unroll
                for (int e = 0; e < 4; ++e) { v0[e] = siluf_(r * acc[ai][0][m][0][e]) * (r * acc[ai][1][m][0][e]); v1[e] = siluf_(r * acc[ai][0][m][1][e]) * (r * acc[ai][1][m][1][e]); }
                *(u32x4*)(FF + (size_t)row * DFF + col0) = pack8(v0, v1); }
    }
};

struct EpiFinal {
    float* out; const bf16_t* h1b; const float* fg; float* sumsq; unsigned* cnt;
    __device__ __forceinline__ void operator()(f32x4 (&acc)[2][2][4][2], const Unit& u, int wr, int wc, int fr, int fq) const {
        const int row0 = u.pm * BM + wr * 64 + fr, col0 = u.pn * BM + wc * 32 + 8 * fq;
#pragma unroll
        for (int ai = 0; ai < 2; ++ai) {
            u32x4 hb[4][2];
#pragma unroll
            for (int m = 0; m < 4; ++m)
#pragma unroll
                for (int bj = 0; bj < 2; ++bj) hb[m][bj] = *(const u32x4*)(h1b + (size_t)(row0 + ai * HALF + m * 16) * 1024 + col0 + bj * HALF);
#pragma unroll
            for (int m = 0; m < 4; ++m) { const int row = row0 + ai * HALF + m * 16; float ss = 0.f;
#pragma unroll
                for (int bj = 0; bj < 2; ++bj) { const size_t o = (size_t)row * 1024 + col0 + bj * HALF;
                    f32x4 r0, r1; unpack8(hb[m][bj], r0, r1);
                    const f32x4 v0 = r0 + acc[ai][bj][m][0], v1 = r1 + acc[ai][bj][m][1];
                    acc[ai][bj][m][0] = v0; acc[ai][bj][m][1] = v1;
                    ss += (v0[0] * v0[0] + v0[1] * v0[1]) + (v0[2] * v0[2] + v0[3] * v0[3]) + (v1[0] * v1[0] + v1[1] * v1[1]) + (v1[2] * v1[2] + v1[3] * v1[3]); }
                ss += __shfl_xor(ss, 16); ss += __shfl_xor(ss, 32);
                if (fq == 0) __hip_atomic_fetch_add(sumsq + row, ss, __ATOMIC_RELAXED, __HIP_MEMORY_SCOPE_AGENT); } }
        asm volatile("s_waitcnt vmcnt(0)" ::: "memory");
        __syncthreads();
        if (threadIdx.x == 0) {
            __threadfence();
            unsigned* c = cnt + u.pm * 64;
            __hip_atomic_fetch_add(c, 1u, __ATOMIC_RELAXED, __HIP_MEMORY_SCOPE_AGENT);
            unsigned sp = 0;
            while (__hip_atomic_load(c, __ATOMIC_RELAXED, __HIP_MEMORY_SCOPE_AGENT) < 4u) { __builtin_amdgcn_s_sleep(1); if (++sp > (1u << 22)) break; }
            __threadfence();
        }
        __syncthreads();
        f32x4 gv[2][2];
#pragma unroll
        for (int bj = 0; bj < 2; ++bj) { gv[bj][0] = *(const f32x4*)(fg + col0 + bj * HALF); gv[bj][1] = *(const f32x4*)(fg + col0 + bj * HALF + 4); }
        float ssv[2][4];
#pragma unroll
        for (int ai = 0; ai < 2; ++ai)
#pragma unroll
            for (int m = 0; m < 4; ++m) ssv[ai][m] = __hip_atomic_load(sumsq + row0 + ai * HALF + m * 16, __ATOMIC_RELAXED, __HIP_MEMORY_SCOPE_AGENT);
#pragma unroll
        for (int ai = 0; ai < 2; ++ai)
#pragma unroll
            for (int m = 0; m < 4; ++m) { const int row = row0 + ai * HALF + m * 16;
                const float rs = __builtin_amdgcn_rsqf(ssv[ai][m] * (1.f / 1024.f) + EPS);
#pragma unroll
                for (int bj = 0; bj < 2; ++bj) { const size_t o = (size_t)row * 1024 + col0 + bj * HALF;
                    *(f32x4*)(out + o) = acc[ai][bj][m][0] * rs * gv[bj][0]; *(f32x4*)(out + o + 4) = acc[ai][bj][m][1] * rs * gv[bj][1]; } }
    }
};
}


#define XB_TMO      128
#define XB_XCNT(j)  (256  + 64 * (j))
#define XB_XSUB(j)  (1280 + 64 * (j))
#define XB_XGEN(j)  (2304 + 64 * (j))
#define XB_TOP      3328
#define XB_TOPGEN   3392
#define XCD_BAR_WORDS 3456
#define XB_SPIN_CAP (1u << 18)
__device__ __forceinline__ unsigned xb_ld(unsigned* p)              { return __hip_atomic_load(p, __ATOMIC_RELAXED, __HIP_MEMORY_SCOPE_AGENT); }
__device__ __forceinline__ unsigned xb_add(unsigned* p, unsigned v) { return __hip_atomic_fetch_add(p, v, __ATOMIC_RELAXED, __HIP_MEMORY_SCOPE_AGENT); }
__device__ __forceinline__ unsigned xb_xcc_id() { return (unsigned)__builtin_amdgcn_s_getreg((3 << 11) | 20) & 0xFu; }
#define XB_SPIN(cond, bar) do { unsigned _sp = 0; while (cond) { __builtin_amdgcn_s_sleep(1); \
    if ((++_sp & 255u) == 0u) { if (xb_ld(&(bar)[XB_TMO])) break; if (_sp > XB_SPIN_CAP) { atomicAdd(&(bar)[XB_TMO], 1u); break; } } } } while (0)
struct XcdBarrier { unsigned* bar; unsigned x; volatile LAS unsigned* st; };
__device__ __forceinline__ XcdBarrier xcd_barrier_post(unsigned* bar, volatile LAS unsigned* st) {
    XcdBarrier b; b.bar = bar; b.x = xb_xcc_id(); b.st = st;
    if (threadIdx.x == 0) (void)xb_add(&bar[XB_XCNT(b.x)], 1u);
    return b;
}
__device__ __forceinline__ void xcd_barrier_complete(unsigned* bar, unsigned x, unsigned& nloc, unsigned& nx) {
    const unsigned G = gridDim.x * gridDim.y * gridDim.z;
    unsigned sum, cnt, mine, sp = 0u;
    for (;;) {
        sum = 0u; cnt = 0u; mine = 0u;
#pragma unroll
        for (unsigned j = 0; j < 16; ++j) { const unsigned c = xb_ld(&bar[XB_XCNT(j)]); sum += c; cnt += (c > 0u) ? 1u : 0u; mine = (j == x) ? c : mine; }
        if (sum == G) break;
        __builtin_amdgcn_s_sleep(1);
        if ((++sp & 255u) == 0u) { if (xb_ld(&bar[XB_TMO])) break; if (sp > XB_SPIN_CAP) { atomicAdd(&bar[XB_TMO], 1u); break; } }
    }
    nloc = mine > 0u ? mine : 1u; nx = cnt > 0u ? cnt : 1u;
}
__device__ __forceinline__ void xcd_barrier(const XcdBarrier& b) {
    asm volatile("s_waitcnt vmcnt(0)" ::: "memory");
    __syncthreads();
    if (threadIdx.x == 0) {
        unsigned* bar = b.bar;
        __builtin_amdgcn_s_waitcnt(0);
        unsigned nloc = b.st[0], nx = b.st[1];
        if (nloc == 0u) { xcd_barrier_complete(bar, b.x, nloc, nx); b.st[0] = nloc; b.st[1] = nx; }
        const unsigned old = xb_add(&bar[XB_XSUB(b.x)], 1u);
        const unsigned gen = old / nloc;
        if (old + 1u == (gen + 1u) * nloc) {
            __builtin_amdgcn_fence(__ATOMIC_RELEASE, "agent");
            asm volatile("s_waitcnt vmcnt(0)" ::: "memory");
            const unsigned og = xb_add(&bar[XB_TOP], 1u);
            const unsigned tg = og / nx;
            if (og + 1u == (tg + 1u) * nx) xb_add(&bar[XB_TOPGEN], 1u);
            else XB_SPIN(xb_ld(&bar[XB_TOPGEN]) == tg, bar);
            __builtin_amdgcn_fence(__ATOMIC_ACQUIRE, "agent");
            xb_add(&bar[XB_XGEN(b.x)], 1u);
            asm volatile("s_waitcnt vmcnt(0)" ::: "memory");
        } else {
            XB_SPIN(xb_ld(&bar[XB_XGEN(b.x)]) == gen, bar);
            __builtin_amdgcn_fence(__ATOMIC_ACQUIRE, "agent");
            asm volatile("s_waitcnt vmcnt(0)" ::: "memory");
        }
    }
    __syncthreads();
}

struct Params { const float* in[19]; float* out; unsigned char* ws; int ph_lo, ph_hi; };

__device__ __forceinline__ void transpose_item(const float* W, int ldw, int K, bf16_t* WT, int kb, int nb, LAS float* scr, int lane, const float* ksc) {
    const int k0 = 64 * kb, n0 = 32 * nb;
    const float* Wl = W + (size_t)(k0 + (lane >> 5)) * ldw + n0 + (lane & 31);
#pragma unroll
    for (int hh = 0; hh < 2; ++hh) { float tv[16];
#pragma unroll
        for (int i = 0; i < 16; ++i) tv[i] = Wl[(size_t)(2 * (16 * hh + i)) * ldw];
        if (ksc) {
#pragma unroll
            for (int i = 0; i < 16; ++i) tv[i] *= ksc[k0 + 2 * (16 * hh + i) + (lane >> 5)]; }
#pragma unroll
        for (int i = 0; i < 16; ++i) { const int kk = 2 * (16 * hh + i) + (lane >> 5); scr[kk * 33 + (lane & 31)] = tv[i]; } }
    asm volatile("s_waitcnt lgkmcnt(0)" ::: "memory");
    const int c = lane & 7;
#pragma unroll
    for (int j = 0; j < 4; ++j) { const int n = (lane >> 3) + 8 * j; const LAS float* s = scr + (8 * c) * 33 + n;
        u32x4 o; o.x = cvt_pk_bf16(s[0 * 33], s[1 * 33]); o.y = cvt_pk_bf16(s[2 * 33], s[3 * 33]); o.z = cvt_pk_bf16(s[4 * 33], s[5 * 33]); o.w = cvt_pk_bf16(s[6 * 33], s[7 * 33]);
        *(u32x4*)(WT + (size_t)(n0 + n) * K + k0 + 8 * c) = o; }
    asm volatile("s_waitcnt lgkmcnt(0)" ::: "memory");
}

__device__ __forceinline__ void p0_prologue(const Params& p, LAS unsigned char* L) {
    const int tid = threadIdx.x, lane = tid & 63, wave = __builtin_amdgcn_readfirstlane(tid >> 6);
    const int G = gridDim.x, gw = blockIdx.x * 8 + wave, NGW = G * 8;
    unsigned char* ws = p.ws;
    const float* w_in = p.in[3];
    {
        LAS float* scr = (LAS float*)(L + wave * 8448);
        constexpr int NITEMS = 3072 + 1024 + 1536 + 2816 + 1408;
        for (int it = gw; it < NITEMS; it += NGW) {
            int r = it; const float* src; int ldw, K = 1024, kb, nb; bf16_t* dst; const float* ksc = nullptr;
            if (r < 3072) { const int pc = r >> 9; r &= 511; kb = r >> 5; nb = r & 31; ldw = NPROJ;
                const int so = pc == 0 ? 0 : pc == 1 ? 3080 : pc == 2 ? 1024 : pc == 3 ? 4104 : pc == 4 ? 2056 : 5144;
                src = w_in + so; dst = (bf16_t*)(ws + (pc < 4 ? WS_WTA : WS_WTB)) + (size_t)(pc < 4 ? pc : pc - 4) * 1048576; }
            else if ((r -= 3072) < 1024) { kb = r >> 6; nb = r & 63; ldw = NPROJ; src = w_in + 6168; dst = (bf16_t*)(ws + WS_WTB) + (size_t)2 * 1048576; }
            else if ((r -= 1024) < 1536) { const int pc = r >> 9; r &= 511; kb = r >> 5; nb = r & 31; ldw = 1024; src = p.in[11 + pc]; dst = (bf16_t*)(ws + WS_WTBM) + (size_t)pc * 1048576; }
            else if ((r -= 1536) < 2816) { const int q = r >> 6; r &= 63; kb = r >> 2; nb = r & 3; const int i = q >> 1, isup = q & 1; ldw = DFF;
                src = p.in[15 + isup] + 128 * i; dst = (bf16_t*)(ws + WS_WTFF) + (size_t)(256 * i + 128 * isup) * 1024; ksc = p.in[14]; }
            else { r -= 2816; kb = r >> 5; nb = r & 31; ldw = 1024; K = DFF; src = p.in[17]; dst = (bf16_t*)(ws + WS_WTD); }
            transpose_item(src, ldw, K, dst, kb, nb, scr, lane, ksc);
        }
    }
    __syncthreads();
    {
        LAS float* xT = (LAS float*)L;
        LAS float* red = (LAS float*)(L + 65536);
#pragma unroll
        for (int rr = 0; rr < 2; ++rr) { const int row = 2 * wave + rr; const f32x4* xr = (const f32x4*)(p.in[1] + (size_t)row * 1024) + lane; const f32x4* gr = (const f32x4*)p.in[2] + lane;
            f32x4 v[4]; float s = 0.f;
#pragma unroll
            for (int j = 0; j < 4; ++j) { v[j] = xr[64 * j]; s += (v[j][0] * v[j][0] + v[j][1] * v[j][1]) + (v[j][2] * v[j][2] + v[j][3] * v[j][3]); }
            const float rstd = __builtin_amdgcn_rsqf(wave_sum(s) * (1.f / 1024.f) + EPS);
#pragma unroll
            for (int j = 0; j < 4; ++j) { const f32x4 gq = gr[64 * j];
#pragma unroll
                for (int e = 0; e < 4; ++e) xT[(256 * j + 4 * lane + e) * 16 + row] = v[j][e] * rstd * gq[e]; } }
        __syncthreads();
        for (int cg0 = blockIdx.x * 16; cg0 < 4096; cg0 += G * 16) {
            const int ci = lane & 15, kq = lane >> 4, dcol = cg0 + ci;
            const int scol = dcol < 1024 ? dcol : dcol < 2048 ? 3080 + (dcol - 1024) : dcol < 3072 ? 1024 + (dcol - 2048) : 4104 + (dcol - 3072);
            float a[16];
#pragma unroll
            for (int r = 0; r < 16; ++r) a[r] = 0.f;
            const int kbase = 128 * wave + kq;
            const float* wp = w_in + (size_t)kbase * NPROJ + scol;
#pragma unroll
            for (int ib = 0; ib < 2; ++ib) { float wv[16];
#pragma unroll
                for (int i = 0; i < 16; ++i) wv[i] = wp[(size_t)(4 * (16 * ib + i)) * NPROJ];
#pragma unroll
                for (int i = 0; i < 16; ++i) { const LAS f32x4* xp = (const LAS f32x4*)(xT + (kbase + 4 * (16 * ib + i)) * 16);
#pragma unroll
                    for (int q = 0; q < 4; ++q) { const f32x4 xv = xp[q];
#pragma unroll
                        for (int e = 0; e < 4; ++e) a[4 * q + e] += xv[e] * wv[i]; }
                    __builtin_amdgcn_sched_barrier(0); } }
#pragma unroll
            for (int r = 0; r < 16; ++r) { a[r] += __shfl_xor(a[r], 16); a[r] += __shfl_xor(a[r], 32); }
            if (kq == 0) {
#pragma unroll
                for (int r = 0; r < 16; ++r) red[(wave * 16 + r) * 16 + ci] = a[r]; }
            __syncthreads();
            if (tid < 256) { const int row = tid >> 4, cc = tid & 15, dc = cg0 + cc; float sm = 0.f;
#pragma unroll
                for (int w = 0; w < 8; ++w) sm += red[(w * 16 + row) * 16 + cc];
                bf16_t* dst = dc < 2048 ? (bf16_t*)(ws + WS_R1) + (size_t)(48 + row) * 2048 + dc : (bf16_t*)(ws + WS_R2) + (size_t)(48 + row) * 2048 + (dc - 2048);
                *dst = f2bf(sm); }
            __syncthreads();
        }
    }
    {
        LAS float* Wsm = (LAS float*)L;
#pragma unroll
        for (int b0 = 0; b0 < 48; b0 += 16) { float tv[16];
#pragma unroll
            for (int i = 0; i < 16; ++i) { const int idx = tid + 512 * (b0 + i); const int k = idx / 24, c = idx - k * 24; const int sc = c < 8 ? 2048 + c : 5128 + (c - 8); tv[i] = w_in[(size_t)k * NPROJ + sc]; }
#pragma unroll
            for (int i = 0; i < 16; ++i) { const int idx = tid + 512 * (b0 + i); const int k = idx / 24, c = idx - k * 24; Wsm[c * 1028 + k] = tv[i]; } }
        __syncthreads();
        float* GI = (float*)(ws + WS_GI); float* GF = (float*)(ws + WS_GF); float* GA = (float*)(ws + WS_GA);
        bf16_t* XN = (bf16_t*)((unsigned char*)p.out + OUT_XN);
        const float bsel = lane < 8 ? p.in[6][lane] : 0.f;
        const f32x4* gr = (const f32x4*)p.in[2] + lane;
        f32x4 g1v[4];
#pragma unroll
        for (int j = 0; j < 4; ++j) g1v[j] = gr[64 * j];
        f32x4 vn[4];
        { const int r = gw; const f32x4* xr = (const f32x4*)(r >= SEQ ? p.in[1] + (size_t)(r - SEQ) * 1024 : p.in[0] + (size_t)r * 1024) + lane;
#pragma unroll
            for (int j = 0; j < 4; ++j) vn[j] = (r < SEQ + 16) ? xr[64 * j] : (f32x4){0.f, 0.f, 0.f, 0.f}; }
        for (int r = gw; r < SEQ + 16; r += NGW) {
            const bool ismeta = r >= SEQ; const int t = ismeta ? 48 + (r - SEQ) : 64 + r;
            f32x4 v[4]; float s = 0.f;
#pragma unroll
            for (int j = 0; j < 4; ++j) { v[j] = vn[j]; s += (v[j][0] * v[j][0] + v[j][1] * v[j][1]) + (v[j][2] * v[j][2] + v[j][3] * v[j][3]); }
            { const int r2 = r + NGW; if (r2 < SEQ + 16) { const f32x4* xr = (const f32x4*)(r2 >= SEQ ? p.in[1] + (size_t)(r2 - SEQ) * 1024 : p.in[0] + (size_t)r2 * 1024) + lane;
#pragma unroll
                for (int j = 0; j < 4; ++j) vn[j] = xr[64 * j]; } }
            const float rstd = __builtin_amdgcn_rsqf(wave_sum(s) * (1.f / 1024.f) + EPS);
#pragma unroll
            for (int j = 0; j < 4; ++j) v[j] = v[j] * rstd * g1v[j];
            if (!ismeta) { u32x2* o8 = (u32x2*)(XN + (size_t)r * 1024) + lane;
#pragma unroll
                for (int j = 0; j < 4; ++j) { u32x2 o; o.x = cvt_pk_bf16(v[j][0], v[j][1]); o.y = cvt_pk_bf16(v[j][2], v[j][3]); o8[64 * j] = o; } }
            float mine = 0.f;
#pragma unroll 4
            for (int c = 0; c < 24; ++c) { float d = 0.f;
#pragma unroll
                for (int j = 0; j < 4; ++j) { const f32x4 wv = *(const LAS f32x4*)(Wsm + c * 1028 + 256 * j + 4 * lane); d += (v[j][0] * wv[0] + v[j][1] * wv[1]) + (v[j][2] * wv[2] + v[j][3] * wv[3]); }
                d = wave_sum(d); if (lane == c) mine = d; }
            if (lane < 4) GI[t * 4 + lane] = mine + bsel;
            else if (lane < 8) GF[t * 4 + lane - 4] = logsigmoidf_(mine + bsel);
            else if (lane < 24) GA[t * 16 + lane - 8] = mine;
        }
    }
}

constexpr int XL_AQ = 0, XL_BK = 17408, XL_KT = 34816, XL_F = 53248;
template <bool SINGLE>
__device__ __forceinline__ void x_phase(const Params& p, LAS unsigned char* L, const int item0, const int NIT, const int GS) {
    const int tid = threadIdx.x, lane = tid & 63, wave = __builtin_amdgcn_readfirstlane(tid >> 6), fr = lane & 15, fq = lane >> 4;
    unsigned char* ws = p.ws;
    const bf16_t* RAW = (const bf16_t*)(ws + WS_R1);
    bf16_t* AQ = (bf16_t*)(ws + WS_AQ); bf16_t* KU = (bf16_t*)(ws + WS_KU); bf16_t* WW = (bf16_t*)((unsigned char*)p.out + OUT_WW);
    const float* GI = (const float*)(ws + WS_GI); const float* GF = (const float*)(ws + WS_GF); const float* GA = (const float*)(ws + WS_GA);
    float* CHB = (float*)(ws + WS_CHB); float* CHM = (float*)(ws + WS_CHM); float* CHG = (float*)(ws + WS_CHG); float* BT = (float*)(ws + WS_BT);
    LAS bf16_t* sAq = (LAS bf16_t*)(L + XL_AQ); LAS bf16_t* sBk = (LAS bf16_t*)(L + XL_BK); LAS bf16_t* sKt = (LAS bf16_t*)(L + XL_KT);
    LAS float* sF = (LAS float*)(L + XL_F);
    LAS float* sga = sF + 256;
    LAS float* part = sF + 256 + 1024;
    const float NINF = -__builtin_inff();
#define X_DECODE(item, c, br, h) const int c = (item) >> 3, br = (((item) >> 2) ^ (c >> 5)) & 1, h = (item) & 3
    const int which = tid >> 8, u = tid & 255, d8 = (u & 15) * 8, l0 = (u >> 4) * 4;
    const int gd = tid & 127, grp = tid >> 7;
    u32x4 raw[7]; float glf = 0.f, gli = 0.f;
    bf16_t rq[16], rk[16]; f32x4 gav = (f32x4){0.f, 0.f, 0.f, 0.f};
#define X_LOAD_M(c, h) do { const int _t0 = (c) * 64; const bf16_t* _src = RAW + which * 512 + (h) * 128 + d8; \
        _Pragma("unroll") for (int _i = 0; _i < 7; ++_i) { const int _t = _t0 + l0 - 3 + _i; raw[_i] = (_t >= 48) ? *(const u32x4*)(_src + (size_t)_t * 2048) : (u32x4){0u, 0u, 0u, 0u}; } \
        if (wave >= 4) { const int _t = _t0 + lane; const bool _v = _t >= 48; glf = _v ? GF[_t * 4 + (h)] : 0.f; gli = _v ? GI[_t * 4 + (h)] : NINF; } } while (0)
#define X_LOAD_G(c, h) do { const int _t0 = (c) * 64; const int _col = (h) * 128 + gd; \
        if (tid < 256) gav = ((const f32x4*)(GA + (size_t)_t0 * 16))[tid]; \
        _Pragma("unroll") for (int _i = 0; _i < 16; ++_i) { const int _t = _t0 + grp * 16 + _i; rq[_i] = (_t >= 48) ? RAW[(size_t)_t * 2048 + 1024 + _col] : (bf16_t)0; rk[_i] = (_t >= 48) ? RAW[(size_t)_t * 2048 + 1536 + _col] : (bf16_t)0; } } while (0)

    int item = item0;
    if (item < NIT) { X_DECODE(item, c, br, h); if (br == 0) X_LOAD_M(c, h); else X_LOAD_G(c, h); }
    bool need = false;
    for (; item < NIT; item += (SINGLE ? NIT : GS)) {
        X_DECODE(item, c, br, h); const int t0 = c * 64, ix = c * 8 + br * 4 + h;
        if (need) { if (br == 0) X_LOAD_M(c, h); else X_LOAD_G(c, h); }
        need = false;
        if (!SINGLE) { const int nx = item + GS; if (nx < NIT) { X_DECODE(nx, c2, br2, h2); if (br2 != br) { if (br2 == 0) X_LOAD_M(c2, h2); else X_LOAD_G(c2, h2); } else need = true; } }
        if (br == 0) {
            const int ch0 = which * 512 + h * 128 + d8;
            const float* cw = p.in[4] + ch0; const float* cb = p.in[5] + ch0;
            f32x4 wv4[4][2];
#pragma unroll
            for (int j = 0; j < 4; ++j) { wv4[j][0] = *(const f32x4*)(cw + j * 1024); wv4[j][1] = *(const f32x4*)(cw + j * 1024 + 4); }
            const f32x4 bv0 = *(const f32x4*)cb, bv1 = *(const f32x4*)(cb + 4);
            if (wave >= 4) {
                const float lf = glf, li = gli;
                const float b = wave_scan_sum(lf);
                const float gtot = __int_as_float(__builtin_amdgcn_readlane(__float_as_int(b), 63));
                const float wl = gtot - b + li;
                const float Ml = wave_max(wl);
                const float e = __expf(wl - Ml);
                const float lib = li - b;
                const float pm = wave_scan_max(lib);
                const bool dead = (pm == NINF);
                sF[128 + 64 * (wave - 4) + lane] = e;
                if (wave == 4) {
                    sF[lane] = lib; sF[64 + lane] = dead ? 0.f : pm;
                    CHB[(c * 4 + h) * 64 + lane] = b; CHM[(c * 4 + h) * 64 + lane] = dead ? 0.f : (b + pm);
                    if (lane == 0) { CHG[(c * 4 + h) * 2] = gtot; CHG[(c * 4 + h) * 2 + 1] = Ml; } }
                asm volatile("s_waitcnt lgkmcnt(0)" ::: "memory");
            }
            {
                float res[4][8];
#pragma unroll
                for (int e2 = 0; e2 < 4; ++e2) {
#pragma unroll
                    for (int o = 0; o < 4; ++o) { float y0 = e2 < 2 ? bv0[2 * e2] : bv1[2 * e2 - 4], y1 = e2 < 2 ? bv0[2 * e2 + 1] : bv1[2 * e2 - 3];
#pragma unroll
                        for (int j = 0; j < 4; ++j) { const unsigned wv = raw[o + j][e2]; y0 += (e2 < 2 ? wv4[j][0][2 * e2] : wv4[j][1][2 * e2 - 4]) * bf_lo(wv); y1 += (e2 < 2 ? wv4[j][0][2 * e2 + 1] : wv4[j][1][2 * e2 - 3]) * bf_hi(wv); }
                        res[o][2 * e2] = siluf_(y0); res[o][2 * e2 + 1] = siluf_(y1); } }
                if (which == 0) {
#pragma unroll
                    for (int o = 0; o < 4; ++o) { u32x4 w; w.x = cvt_pk_bf16(res[o][0] * QSCALE, res[o][1] * QSCALE); w.y = cvt_pk_bf16(res[o][2] * QSCALE, res[o][3] * QSCALE);
                        w.z = cvt_pk_bf16(res[o][4] * QSCALE, res[o][5] * QSCALE); w.w = cvt_pk_bf16(res[o][6] * QSCALE, res[o][7] * QSCALE);
                        *(LAS u32x4*)(sAq + (l0 + o) * 136 + d8) = w; *(u32x4*)(AQ + (size_t)(t0 + l0 + o) * 1024 + h * 128 + d8) = w; }
                } else {
                    float ev[4];
#pragma unroll
                    for (int o = 0; o < 4; ++o) { ev[o] = sF[128 + 64 * (wave - 4) + l0 + o];
                        u32x4 w; w.x = cvt_pk_bf16(res[o][0], res[o][1]); w.y = cvt_pk_bf16(res[o][2], res[o][3]); w.z = cvt_pk_bf16(res[o][4], res[o][5]); w.w = cvt_pk_bf16(res[o][6], res[o][7]);
                        *(LAS u32x4*)(sBk + (l0 + o) * 136 + d8) = w; }
#pragma unroll
                    for (int e = 0; e < 8; ++e) { u32x2 w; w.x = cvt_pk_bf16(res[0][e] * ev[0], res[1][e] * ev[1]); w.y = cvt_pk_bf16(res[2][e] * ev[2], res[3][e] * ev[3]);
                        *(LAS u32x2*)(sKt + (d8 + e) * 72 + l0) = w; }
                }
            }
        } else {
            const int d = gd, col = h * 128 + d;
            float a2[16];
#pragma unroll
            for (int r = 0; r < 16; ++r) a2[r] = p.in[7][r * 512 + col];
            const float bias = p.in[8][col];
            if (tid < 256) ((LAS f32x4*)sga)[tid] = gav;
            LDS_BARRIER();
            float cs[16]; float run = 0.f;
#pragma unroll
            for (int i = 0; i < 16; ++i) { const int l = grp * 16 + i; float za = bias;
#pragma unroll
                for (int q = 0; q < 4; ++q) { const f32x4 gv = *(const LAS f32x4*)(sga + l * 16 + 4 * q); za += (gv[0] * a2[4 * q] + gv[1] * a2[4 * q + 1]) + (gv[2] * a2[4 * q + 2] + gv[3] * a2[4 * q + 3]); }
                const float la = (t0 + l >= 48) ? logsigmoidf_(za) * (1.f / 16.f) : 0.f;
                run += la; cs[i] = run; }
            part[grp * 128 + d] = run;
            LDS_BARRIER();
            float off = 0.f, btot = 0.f;
#pragma unroll
            for (int g2 = 0; g2 < 4; ++g2) { const float pv = part[g2 * 128 + d]; btot += pv; if (g2 < grp) off += pv; }
            if (grp == 0) BT[(c * 4 + h) * 128 + d] = btot;
            float kend[16];
#pragma unroll
            for (int i = 0; i < 16; ++i) { const int l = grp * 16 + i, t = t0 + l; const float bc = cs[i] + off;
                const float gq = bf2f(rq[i]), gk = bf2f(rk[i]);
                const bf16_t qd = f2bf(gq * QSCALE * __expf(bc));
                sAq[l * 136 + d] = qd; AQ[(size_t)t * 1024 + 512 + col] = qd;
                sBk[l * 136 + d] = f2bf(gk * __expf(-bc));
                kend[i] = gk * __expf(btot - bc); }
            u32x4 w0, w1;
            w0.x = cvt_pk_bf16(kend[0], kend[1]); w0.y = cvt_pk_bf16(kend[2], kend[3]); w0.z = cvt_pk_bf16(kend[4], kend[5]); w0.w = cvt_pk_bf16(kend[6], kend[7]);
            w1.x = cvt_pk_bf16(kend[8], kend[9]); w1.y = cvt_pk_bf16(kend[10], kend[11]); w1.z = cvt_pk_bf16(kend[12], kend[13]); w1.w = cvt_pk_bf16(kend[14], kend[15]);
            *(LAS u32x4*)(sKt + d * 72 + grp * 16) = w0; *(LAS u32x4*)(sKt + d * 72 + grp * 16 + 8) = w1;
        }
        LDS_BARRIER();
        {
            const int jt = wave & 3, sh = wave >> 2, j = jt * 16 + fr;
            const float pmj = br == 0 ? sF[64 + j] : 0.f;
#pragma unroll
            for (int q = 0; q < 2; ++q) { const int st = 2 * sh + q;
                f32x4 acc = (f32x4){0.f, 0.f, 0.f, 0.f};
                if (st <= jt) {
#pragma unroll
                    for (int ks = 0; ks < 4; ++ks) { const bf16x8 kf = *(const LAS bf16x8*)(sBk + (st * 16 + fr) * 136 + ks * 32 + fq * 8), qf = *(const LAS bf16x8*)(sAq + j * 136 + ks * 32 + fq * 8);
                        acc = MFMA16(kf, qf, acc); }
#pragma unroll
                    for (int i = 0; i < 4; ++i) { const int s2 = st * 16 + fq * 4 + i; float dd = 0.f; if (s2 <= j) dd = br == 0 ? __expf(sF[s2] - pmj) : 1.f; acc[i] = (s2 <= j) ? acc[i] * dd : 0.f; }
                }
                u32x2 w; w.x = cvt_pk_bf16(acc[0], acc[1]); w.y = cvt_pk_bf16(acc[2], acc[3]);
                *(u32x2*)(WW + (size_t)ix * 4096 + j * 64 + st * 16 + fq * 4) = w; }
        }
#pragma unroll
        for (int i = 0; i < 2; ++i) { const int pc = tid + 512 * i, row = pc >> 3, sg = pc & 7;
            *(u32x4*)(KU + (size_t)ix * 8192 + pc * 8) = *(const LAS u32x4*)(sKt + row * 72 + sg * 8); }
        LDS_BARRIER();
    }
#undef X_DECODE
#undef X_LOAD_M
#undef X_LOAD_G
}

constexpr int SL_AQ = 0, SL_W = 17408, SL_KT = 26624, SL_VT = 45056, SL_CB = 56576, SL_CH = 78336, SL_ROW = 80896;
template <bool ML, bool PASSC>
__device__ __forceinline__ void scan_item(const Params& p, LAS unsigned char* L, const int qid, const int h, const int sl, const int g) {
    constexpr int NVT = ML ? 5 : 4, NT = ML ? 3 : 2;
    constexpr int NG = PASSC ? 1 : 4, TG = 512 / NG;
    constexpr int NLQ = 1024 / TG, NLW = 512 / TG, NLK = 1024 / TG, NLV = 512 / TG;
    const int tid = threadIdx.x, lane = tid & 63, wave = __builtin_amdgcn_readfirstlane(tid >> 6), fr = lane & 15, fq = lane >> 4;
    const int br = ML ? 0 : 1; const int item = qid * 4 + sl;
    const int gi = wave / (8 / NG), gt = tid & (TG - 1);
    unsigned char* ws = p.ws;
    const bf16_t* AQ = (const bf16_t*)(ws + WS_AQ); const bf16_t* KU = (const bf16_t*)(ws + WS_KU); const bf16_t* WW = (const bf16_t*)((const unsigned char*)p.out + OUT_WW);
    const bf16_t* V = (const bf16_t*)(ws + WS_R2); bf16_t* H = (bf16_t*)(ws + WS_R1); float* HSS = (float*)(ws + WS_HSS);
    const float* CHB = (const float*)(ws + WS_CHB); const float* CHM = (const float*)(ws + WS_CHM); const float* CHG = (const float*)(ws + WS_CHG); const float* BT = (const float*)(ws + WS_BT);
    f32x4* SEG = (f32x4*)(ws + WS_SEG);
    LAS bf16_t* sAq = (LAS bf16_t*)(L + SL_AQ); LAS bf16_t* sW = (LAS bf16_t*)(L + SL_W); LAS bf16_t* sKt = (LAS bf16_t*)(L + SL_KT);
    LAS bf16_t* sVt = (LAS bf16_t*)(L + SL_VT); LAS bf16_t* sCb = (LAS bf16_t*)(L + SL_CB); LAS float* sCH = (LAS float*)(L + SL_CH); LAS float* sRow = (LAS float*)(L + SL_ROW);
    const int cs = seg_start_b(ML, g), ce = seg_start_b(ML, g + 1);
    const int dt = wave, jt = wave & 3, vh = wave >> 2;

    u32x4 rq[NLQ], rw[NLW], rk[NLK], rv[NLV]; float rs = 0.f;
#define SCAN_LOAD(c) do { const int _t0 = (c) * 64; const int _ix = (c) * 8 + br * 4 + h; \
        if (PASSC) { _Pragma("unroll") for (int _i = 0; _i < NLQ; ++_i) { const int _p = gt + TG * _i; rq[_i] = *(const u32x4*)(AQ + (size_t)(_t0 + (_p >> 4)) * 1024 + br * 512 + h * 128 + (_p & 15) * 8); } \
            _Pragma("unroll") for (int _i = 0; _i < NLW; ++_i) rw[_i] = *(const u32x4*)(WW + (size_t)_ix * 4096 + (gt + TG * _i) * 8); } \
        _Pragma("unroll") for (int _i = 0; _i < NLK; ++_i) rk[_i] = *(const u32x4*)(KU + (size_t)_ix * 8192 + (gt + TG * _i) * 8); \
        _Pragma("unroll") for (int _i = 0; _i < NLV; ++_i) { const int _p = gt + TG * _i, _l = _p & 63, _pc = _p >> 6; \
            rv[_i] = (_t0 + _l >= 48) ? *(const u32x4*)(V + (size_t)(_t0 + _l) * 2048 + br * 1024 + h * 256 + sl * 64 + _pc * 8) : (u32x4){0u, 0u, 0u, 0u}; } \
        if (gt < 128) { if (ML) { if (PASSC) rs = (gt < 64) ? CHB[((c) * 4 + h) * 64 + gt] : CHM[((c) * 4 + h) * 64 + gt - 64]; } \
        else rs = BT[(size_t)((c) * 4 + h) * 128 + gt]; } } while (0)
#define SCAN_WRITE() do { \
        if (PASSC) { _Pragma("unroll") for (int _i = 0; _i < NLQ; ++_i) { const int _p = gt + TG * _i; *(LAS u32x4*)(sAq + (_p >> 4) * 136 + (_p & 15) * 8) = rq[_i]; } \
            _Pragma("unroll") for (int _i = 0; _i < NLW; ++_i) { const int _p = gt + TG * _i; *(LAS u32x4*)(sW + (_p >> 3) * 72 + (_p & 7) * 8) = rw[_i]; } } \
        _Pragma("unroll") for (int _i = 0; _i < NLK; ++_i) { const int _p = gt + TG * _i; *(LAS u32x4*)(sKt + (_p >> 3) * 72 + (_p & 7) * 8) = rk[_i]; } \
        _Pragma("unroll") for (int _i = 0; _i < NLV; ++_i) { const int _p = gt + TG * _i, _l = _p & 63, _pc = _p >> 6; \
            _Pragma("unroll") for (int _e = 0; _e < 4; ++_e) { const unsigned _wv = rv[_i][_e]; sVt[(_pc * 8 + 2 * _e) * 72 + _l] = (bf16_t)(_wv & 0xffffu); sVt[(_pc * 8 + 2 * _e + 1) * 72 + _l] = (bf16_t)(_wv >> 16); } } \
        if ((!ML || PASSC) && gt < 128) sRow[gt] = rs; } while (0)
#pragma unroll
    for (int k = 0; k < NG; ++k) { if (gi == k && cs + k < ce) SCAN_LOAD(cs + k); }

    if (ML) { if (tid < 128) { const int row = 64 + (tid >> 3), sg = tid & 7; const unsigned one = (row == 64) ? 0x3F803F80u : 0u; *(LAS u32x4*)(sVt + row * 72 + sg * 8) = (u32x4){one, one, one, one}; }
        for (int i = tid; i < NCH * 2; i += 512) sCH[i] = CHG[(i >> 1) * 8 + h * 2 + (i & 1)]; }
    LDS_BARRIER();

    f32x4 st[NVT];
#pragma unroll
    for (int vt = 0; vt < NVT; ++vt) st[vt] = (f32x4){0.f, 0.f, 0.f, 0.f};
    float mrun = 0.f; f32x4 btacc = (f32x4){0.f, 0.f, 0.f, 0.f};
    for (int gp = 0; gp < g; ++gp) {
        const int c0 = seg_start_b(ML, gp), c1 = seg_start_b(ML, gp + 1);
        f32x4 F;
        if (ML) { float Fl = 0.f;
#pragma unroll 8
            for (int c = c0; c < c1; ++c) { const float gc = sCH[2 * c], Ml = sCH[2 * c + 1]; const float mn = fmaxf(gc + mrun, Ml); Fl += gc + mrun - mn; mrun = mn; }
            const float f = __expf(Fl); F = (f32x4){f, f, f, f}; }
        else { f32x4 s4 = (f32x4){0.f, 0.f, 0.f, 0.f}; if (PASSC) s4 = *(const f32x4*)((const float*)(ws + WS_SEGBT) + (size_t)(h * 8 + gp) * 128 + dt * 16 + fq * 4);
            F = (f32x4){__expf(s4[0]), __expf(s4[1]), __expf(s4[2]), __expf(s4[3])}; }
        if (PASSC) { const int it2 = (qid - g + gp) * 4 + sl;
#pragma unroll
            for (int vt = 0; vt < NVT; ++vt) { const f32x4 Lv = SEG[((size_t)(it2 * 8 + dt) * 5 + vt) * 64 + lane]; st[vt] = F * st[vt] + Lv; } }
    }
    if (PASSC) {
#pragma unroll
        for (int vt = 0; vt < NVT; ++vt) { u32x2 w; w.x = cvt_pk_bf16(st[vt][0], st[vt][1]); w.y = cvt_pk_bf16(st[vt][2], st[vt][3]); *(LAS u32x2*)(sCb + (vt * 16 + fr) * 136 + dt * 16 + fq * 4) = w; }
    }

    for (int c = cs; c < ce; ++c) {
        if (gi == ((c - cs) & (NG - 1))) { SCAN_WRITE(); if (c + NG < ce) SCAN_LOAD(c + NG); }
        LDS_BARRIER();
        float a_c = 1.f, u_c = 1.f, a_int = 1.f, r_int = 1.f, clampv = 1.f; f32x4 dec = (f32x4){1.f, 1.f, 1.f, 1.f};
        if (ML) { const float gc = sCH[2 * c], Ml = sCH[2 * c + 1]; const float mn = fmaxf(gc + mrun, Ml); a_c = __expf(gc + mrun - mn); u_c = __expf(Ml - mn);
            if (PASSC && c > 0) { const float bj = sRow[jt * 16 + fr], mr = sRow[64 + jt * 16 + fr]; const float mrow = fmaxf(bj + mrun, mr);
                a_int = __expf(bj + mrun - mrow); r_int = __expf(mr - mrow); clampv = __expf(-mrow); }
            mrun = mn; }
        else { const f32x4 b4 = *(const LAS f32x4*)(sRow + dt * 16 + fq * 4); dec = (f32x4){__expf(b4[0]), __expf(b4[1]), __expf(b4[2]), __expf(b4[3])}; btacc += b4; }
        if (PASSC && c > 0) {
            f32x4 ai[NT], ae[NT];
#pragma unroll
            for (int q = 0; q < NT; ++q) { ai[q] = (f32x4){0.f, 0.f, 0.f, 0.f}; ae[q] = (f32x4){0.f, 0.f, 0.f, 0.f}; }
#pragma unroll
            for (int ks = 0; ks < 2; ++ks) { const bf16x8 wf = *(const LAS bf16x8*)(sW + (jt * 16 + fr) * 72 + ks * 32 + fq * 8);
#pragma unroll
                for (int q = 0; q < NT; ++q) { const int vt = q < 2 ? 2 * vh + q : 4; const bf16x8 vf = *(const LAS bf16x8*)(sVt + (vt * 16 + fr) * 72 + ks * 32 + fq * 8); ai[q] = MFMA16(vf, wf, ai[q]); } }
#pragma unroll
            for (int ks = 0; ks < 4; ++ks) { const bf16x8 af = *(const LAS bf16x8*)(sAq + (jt * 16 + fr) * 136 + ks * 32 + fq * 8);
#pragma unroll
                for (int q = 0; q < NT; ++q) { const int vt = q < 2 ? 2 * vh + q : 4; const bf16x8 cf = *(const LAS bf16x8*)(sCb + (vt * 16 + fr) * 136 + ks * 32 + fq * 8); ae[q] = MFMA16(cf, af, ae[q]); } }
            float dn = 1.f;
            if (ML) { const float denv = a_int * ae[NT - 1][0] + r_int * ai[NT - 1][0]; const float den = __shfl(denv, fr); dn = __builtin_amdgcn_rcpf(fmaxf(fabsf(den), clampv)); }
            const int row = (c - 1) * 64 + jt * 16 + fr; float ss = 0.f;
#pragma unroll
            for (int q = 0; q < 2; ++q) { f32x4 hv;
#pragma unroll
                for (int i = 0; i < 4; ++i) { hv[i] = ML ? (a_int * ae[q][i] + r_int * ai[q][i]) * dn : (ae[q][i] + ai[q][i]); ss += hv[i] * hv[i]; }
                u32x2 w; w.x = cvt_pk_bf16(hv[0], hv[1]); w.y = cvt_pk_bf16(hv[2], hv[3]);
                *(u32x2*)(H + (size_t)row * 2048 + br * 1024 + h * 256 + sl * 64 + (2 * vh + q) * 16 + fq * 4) = w; }
            ss += __shfl_xor(ss, 16); ss += __shfl_xor(ss, 32);
            if (fq == 0) HSS[(size_t)row * 64 + br * 32 + h * 8 + sl * 2 + vh] = ss;
        }
        f32x4 dl[NVT];
#pragma unroll
        for (int vt = 0; vt < NVT; ++vt) dl[vt] = (f32x4){0.f, 0.f, 0.f, 0.f};
#pragma unroll
        for (int ks = 0; ks < 2; ++ks) { const bf16x8 kf = *(const LAS bf16x8*)(sKt + (dt * 16 + fr) * 72 + ks * 32 + fq * 8);
#pragma unroll
            for (int vt = 0; vt < NVT; ++vt) { const bf16x8 vf = *(const LAS bf16x8*)(sVt + (vt * 16 + fr) * 72 + ks * 32 + fq * 8); dl[vt] = MFMA16(kf, vf, dl[vt]); } }
        LDS_BARRIER();
#pragma unroll
        for (int vt = 0; vt < NVT; ++vt) { if (ML) st[vt] = st[vt] * a_c + dl[vt] * u_c; else st[vt] = st[vt] * dec + dl[vt];
            if (PASSC) { u32x2 w; w.x = cvt_pk_bf16(st[vt][0], st[vt][1]); w.y = cvt_pk_bf16(st[vt][2], st[vt][3]); *(LAS u32x2*)(sCb + (vt * 16 + fr) * 136 + dt * 16 + fq * 4) = w; } }
    }
#undef SCAN_LOAD
#undef SCAN_WRITE
    if (!PASSC) {
#pragma unroll
        for (int vt = 0; vt < NVT; ++vt) SEG[((size_t)(item * 8 + dt) * 5 + vt) * 64 + lane] = st[vt];
        if (!ML && sl == 0 && fr == 0) *(f32x4*)((float*)(ws + WS_SEGBT) + (size_t)(h * 8 + g) * 128 + dt * 16 + fq * 4) = btacc;
    }
    LDS_BARRIER();
}

__device__ __forceinline__ void scan_phase(const Params& p, LAS unsigned char* L, const bool passC) {
    for (int b = blockIdx.x; b < 256; b += gridDim.x) {
        const int x = b & 7, y = b >> 3, qid = x + 8 * (y >> 2), sl = y & 3;
        const bool ml = qid < 4 * NSEG_M;
        const int qq = ml ? qid : qid - 4 * NSEG_M, ns = ml ? NSEG_M : NSEG_G, h = qq / ns, g = qq - h * ns;
        if (!passC && g == ns - 1) continue;
        if (passC) { if (ml) scan_item<true, true>(p, L, qid, h, sl, g); else scan_item<false, true>(p, L, qid, h, sl, g); }
        else { if (ml) scan_item<true, false>(p, L, qid, h, sl, g); else scan_item<false, false>(p, L, qid, h, sl, g); }
    }
}

__global__ void __launch_bounds__(512, 2) fwd_megakernel(Params p) {
    extern __shared__ __attribute__((aligned(16))) unsigned char lds_raw[];
    LAS unsigned char* L = (LAS unsigned char*)lds_raw;
    cg::grid_group grid = cg::this_grid();
    const int lo = p.ph_lo, hi = p.ph_hi, G = gridDim.x;
    unsigned char* ws = p.ws;
#define IN(k) (lo <= (k) && (k) < hi)
#define SEAM(k) do { if (IN(k) && IN((k) + 1)) xcd_barrier(bar); } while (0)
    if (lo < 0) grid.sync();
    if (threadIdx.x < 16) ((LAS unsigned*)(L + MISC_OFF))[threadIdx.x] = 0u;
    __syncthreads();
    XcdBarrier bar = xcd_barrier_post((unsigned*)(ws + WS_BAR), (volatile LAS unsigned*)(L + MISC_OFF));
    if (IN(0)) p0_prologue(p, L);
    SEAM(0);
    if (IN(1)) { pg8::Gemm g{(const bf16_t*)((const unsigned char*)p.out + OUT_XN), (const bf16_t*)(ws + WS_WTA), SEQ, 4096, 1024, 1024, 0, 0};
        pg8::StaticOrder S; S.init(SEQ, 4096, G, (int)blockIdx.x);
        pg8::EpiQKV E{(bf16_t*)(ws + WS_R1), (bf16_t*)(ws + WS_R2)};
        pg8::gemm_phase<pg8::EpiQKV, pg8::StaticOrder>(L, g, S, E); }
    SEAM(1);
    if (IN(2)) x_phase<false>(p, L, (int)blockIdx.x, (G == 256 ? (NCH - 1) * 8 : NCH * 8), G);
    SEAM(2);
    if (IN(3)) {
        if (G == 256) { const int b = blockIdx.x, x = b & 7, y = b >> 3, qid = x + 8 * (y >> 2), sl = y & 3; const bool ml = qid < 4 * NSEG_M;
            const int qq = ml ? qid : qid - 4 * NSEG_M, ns = ml ? NSEG_M : NSEG_G, hh = qq / ns, gg = qq - hh * ns;
            if (gg == ns - 1 && sl == 0) { const int it = (NCH - 1) * 8 + (ml ? 0 : 4) + hh; x_phase<true>(p, L, it, it + 1, 256); } }
        scan_phase(p, L, false);
    }
    SEAM(3);
    if (IN(4)) scan_phase(p, L, true);
    SEAM(4);
    if (IN(5)) { pg8::Gemm g{(const bf16_t*)((const unsigned char*)p.out + OUT_XN), (const bf16_t*)(ws + WS_WTB), SEQ, 4096, 1024, 1024, 0, 0};
        pg8::StaticOrder S; S.init(SEQ, 4096, G, (int)blockIdx.x);
        pg8::EpiGate E{(bf16_t*)(ws + WS_R1), (bf16_t*)(ws + WS_R2), (const float*)(ws + WS_HSS), p.in[9], p.in[10]};
        pg8::gemm_phase<pg8::EpiGate, pg8::StaticOrder>(L, g, S, E); }
    SEAM(5);
    if (IN(6)) { pg8::Gemm g{(const bf16_t*)(ws + WS_R1), (const bf16_t*)(ws + WS_WTBM), SEQ, 1024, 1024, 2048, (size_t)1024 * 2, (size_t)2 * MiB};
        pg8::TwoPassOrder S; S.init(SEQ, 1024, G, (int)blockIdx.x);
        pg8::EpiMerge E{(bf16_t*)(ws + WS_AQ), (const bf16_t*)(ws + WS_R2)};
        pg8::gemm_phase<pg8::EpiMerge, pg8::TwoPassOrder>(L, g, S, E); }
    SEAM(6);
    if (IN(7)) { pg8::Gemm g{(const bf16_t*)(ws + WS_AQ), (const bf16_t*)(ws + WS_WTO), SEQ, 1024, 1024, 1024, 0, 0};
        pg8::StaticOrder S; S.init(SEQ, 1024, G, (int)blockIdx.x);
        pg8::EpiResid E{p.in[0], (bf16_t*)(ws + WS_KU), (float*)(ws + WS_SS1)};
        pg8::gemm_phase<pg8::EpiResid, pg8::StaticOrder>(L, g, S, E); }
    SEAM(7);
    if (IN(8)) { pg8::Gemm g{(const bf16_t*)(ws + WS_KU), (const bf16_t*)(ws + WS_WTFF), SEQ, 2 * DFF, 1024, 1024, 0, 0};
        pg8::StaticOrder S; S.init(SEQ, 2 * DFF, G, (int)blockIdx.x);
        pg8::EpiFF E{(bf16_t*)(ws + WS_FF), (const float*)(ws + WS_SS1)};
        pg8::gemm_phase<pg8::EpiFF, pg8::StaticOrder>(L, g, S, E); }
    SEAM(8);
    if (IN(9)) { pg8::Gemm g{(const bf16_t*)(ws + WS_FF), (const bf16_t*)(ws + WS_WTD), SEQ, 1024, DFF, DFF, 0, 0};
        pg8::StaticOrder S; S.init(SEQ, 1024, G, (int)blockIdx.x);
        pg8::EpiFinal E{p.out, (const bf16_t*)(ws + WS_KU), p.in[18], (float*)(ws + WS_SS2), (unsigned*)(ws + WS_PCNT)};
        pg8::gemm_phase<pg8::EpiFinal, pg8::StaticOrder>(L, g, S, E); }
#undef IN
#undef SEAM
}

extern "C" void kernel_launch(void* const* d_in, const int* in_sizes, int n_in, void* d_out, int out_size, void* d_ws, size_t ws_size, hipStream_t stream) {
    static int grid = 0;
    if (grid == 0) {
        if (n_in != 19 || out_size != SEQ * DM || ws_size < WS_END) { fprintf(stderr, "kernel_launch: unexpected sizes (n_in %d out %d ws %zu)\n", n_in, out_size, ws_size); grid = -1; return; }
        int dev = 0, cus = 0, per_cu = 0;
        (void)hipGetDevice(&dev); (void)hipDeviceGetAttribute(&cus, hipDeviceAttributeMultiprocessorCount, dev);
        if (hipFuncSetAttribute((const void*)fwd_megakernel, hipFuncAttributeMaxDynamicSharedMemorySize, LDS_BYTES) != hipSuccess) { fprintf(stderr, "kernel_launch: hipFuncSetAttribute failed\n"); grid = -1; return; }
        if (hipOccupancyMaxActiveBlocksPerMultiprocessor(&per_cu, (const void*)fwd_megakernel, 512, LDS_BYTES) != hipSuccess || per_cu < 1) { fprintf(stderr, "kernel_launch: occupancy query says %d\n", per_cu); per_cu = 1; }
        (void)hipGetLastError();
        grid = cus * 1;
        if (grid <= 0) grid = 256;
    }
    if (grid < 0) return;
    if (hipMemsetAsync(d_ws, 0, CTL_ZERO_BYTES, stream) != hipSuccess) { fprintf(stderr, "kernel_launch: memset failed\n"); return; }
    Params a{};
    for (int i = 0; i < 19; ++i) a.in[i] = (const float*)d_in[i];
    a.out = (float*)d_out; a.ws = (unsigned char*)d_ws;
#if N_LAUNCH_MODE == 1
    a.ph_lo = 0; a.ph_hi = 10;
    void* args[] = {&a};
    hipError_t e = hipLaunchCooperativeKernel((const void*)fwd_megakernel, dim3(grid), dim3(512), args, LDS_BYTES, stream);
    if (e != hipSuccess) fprintf(stderr, "cooperative launch failed: %s (grid %d)\n", hipGetErrorString(e), grid);
#else
    for (int ph = 0; ph < 10; ++ph) { a.ph_lo = ph; a.ph_hi = ph + 1;
        hipLaunchKernelGGL(fwd_megakernel, dim3(grid), dim3(512), LDS_BYTES, stream, a); }
#endif
}
```

```cpp
#include <hip/hip_runtime.h>
#include <hip/hip_cooperative_groups.h>
#include <cstdio>
#include <cstdint>
namespace cg = cooperative_groups;

#define LAS __attribute__((address_space(3)))
typedef unsigned short bf16_t;
typedef short bf16x8 __attribute__((ext_vector_type(8)));
typedef float f32x4 __attribute__((ext_vector_type(4)));
typedef unsigned u32x4 __attribute__((ext_vector_type(4)));
typedef unsigned u32x2 __attribute__((ext_vector_type(2)));

#ifndef N_LAUNCH_MODE
#define N_LAUNCH_MODE 1
#endif

constexpr int DM = 1024, SEQ = 16384, TP = SEQ + 64, NCH = 257, NPROJ = 8216, DFF = 2816;
constexpr float EPS = 1e-6f;
constexpr float QSCALE = 0.08838834764831845f;
constexpr int NSEG_M = 9, NSEG_G = 7;
__host__ __device__ constexpr int seg_start_b(bool ml, int g) { return ml ? (g * 257 + 4) / 9 : (g * 257 + 3) / 7; }

constexpr size_t MiB = 1u << 20;
constexpr size_t WS_SS1 = 0, WS_SS2 = 65536, WS_BAR = 131072, WS_PCNT = 147456, CTL_ZERO_BYTES = 163840;
constexpr size_t WS_GI = 1 * MiB, WS_GF = 1 * MiB + 512 * 1024, WS_GA = 2 * MiB;
constexpr size_t WS_HSS = 4 * MiB;
constexpr size_t WS_CHB = 8 * MiB, WS_CHM = 8 * MiB + 512 * 1024, WS_CHG = 9 * MiB, WS_BT = 9 * MiB + 65536, WS_SEGBT = 9 * MiB + 768 * 1024;
constexpr size_t WS_WTA = 10 * MiB, WS_WTB = 18 * MiB, WS_WTBM = 26 * MiB, WS_WTO = 30 * MiB, WS_WTFF = 32 * MiB, WS_WTD = 43 * MiB;
constexpr size_t WS_R1 = 49 * MiB;
constexpr size_t WS_R2 = 114 * MiB;
constexpr size_t WS_AQ = 179 * MiB;
constexpr size_t WS_KU = 212 * MiB;
constexpr size_t WS_SEG = 245 * MiB;
constexpr size_t WS_FF = WS_R1;
constexpr size_t WS_END = 256 * MiB;
constexpr size_t OUT_XN = 0, OUT_WW = 32 * MiB;

constexpr int LDS_BYTES = 147456, MISC_OFF = 146432;

typedef float f32x2_t __attribute__((ext_vector_type(2)));
typedef __bf16 bf16x2_t __attribute__((ext_vector_type(2)));
__device__ __forceinline__ unsigned cvt_pk_bf16(float lo, float hi) { const f32x2_t v = {lo, hi}; const bf16x2_t b = __builtin_convertvector(v, bf16x2_t); return __builtin_bit_cast(unsigned, b); }
__device__ __forceinline__ float bf_lo(unsigned u) { return __uint_as_float(u << 16); }
__device__ __forceinline__ float bf_hi(unsigned u) { return __uint_as_float(u & 0xffff0000u); }
__device__ __forceinline__ float bf2f(bf16_t b) { return __uint_as_float(((unsigned)b) << 16); }
__device__ __forceinline__ bf16_t f2bf(float f) { return (bf16_t)(cvt_pk_bf16(f, 0.f) & 0xffffu); }
#define DPP_F(old, src, ctrl, rmask, bc) __int_as_float(__builtin_amdgcn_update_dpp(__float_as_int(old), __float_as_int(src), (ctrl), (rmask), 0xf, (bc)))
__device__ __forceinline__ float wave_sum(float v) {
    v += DPP_F(0.f, v, 0xB1, 0xf, true);
    v += DPP_F(0.f, v, 0x4E, 0xf, true);
    v += DPP_F(0.f, v, 0x141, 0xf, true);
    v += DPP_F(0.f, v, 0x140, 0xf, true);
    v += DPP_F(0.f, v, 0x142, 0xa, false);
    v += DPP_F(0.f, v, 0x143, 0xc, false);
    return __int_as_float(__builtin_amdgcn_readlane(__float_as_int(v), 63));
}
__device__ __forceinline__ float wave_max(float v) {
    v = fmaxf(v, DPP_F(v, v, 0xB1, 0xf, false));
    v = fmaxf(v, DPP_F(v, v, 0x4E, 0xf, false));
    v = fmaxf(v, DPP_F(v, v, 0x141, 0xf, false));
    v = fmaxf(v, DPP_F(v, v, 0x140, 0xf, false));
    v = fmaxf(v, DPP_F(v, v, 0x142, 0xa, false));
    v = fmaxf(v, DPP_F(v, v, 0x143, 0xc, false));
    return __int_as_float(__builtin_amdgcn_readlane(__float_as_int(v), 63));
}
__device__ __forceinline__ float wave_scan_sum(float v) {
    v += DPP_F(0.f, v, 0x111, 0xf, true); v += DPP_F(0.f, v, 0x112, 0xf, true); v += DPP_F(0.f, v, 0x114, 0xf, true); v += DPP_F(0.f, v, 0x118, 0xf, true);
    v += DPP_F(0.f, v, 0x142, 0xa, false); v += DPP_F(0.f, v, 0x143, 0xc, false);
    return v;
}
__device__ __forceinline__ float wave_scan_max(float v) {
    v = fmaxf(v, DPP_F(v, v, 0x111, 0xf, false)); v = fmaxf(v, DPP_F(v, v, 0x112, 0xf, false)); v = fmaxf(v, DPP_F(v, v, 0x114, 0xf, false)); v = fmaxf(v, DPP_F(v, v, 0x118, 0xf, false));
    v = fmaxf(v, DPP_F(v, v, 0x142, 0xa, false)); v = fmaxf(v, DPP_F(v, v, 0x143, 0xc, false));
    return v;
}
__device__ __forceinline__ float sigmoidf_(float x) { return __builtin_amdgcn_rcpf(1.f + __expf(-x)); }
__device__ __forceinline__ float siluf_(float x) { return x * __builtin_amdgcn_rcpf(1.f + __expf(-x)); }
__device__ __forceinline__ float logsigmoidf_(float z) { return fminf(z, 0.f) - __logf(1.f + __expf(-fabsf(z))); }
#define LDS_BARRIER() do { asm volatile("s_waitcnt lgkmcnt(0)" ::: "memory"); __builtin_amdgcn_s_barrier(); asm volatile("" ::: "memory"); } while (0)
#define MFMA16(a, b, c) __builtin_amdgcn_mfma_f32_16x16x32_bf16((a), (b), (c), 0, 0, 0)

namespace pg8 {
constexpr int BM = 256, BK = 64, HALF = 128, HTB = HALF * BK * 2, NXCD = 8, WGM = 1;
__host__ __device__ __forceinline__ int lds_byte(int r, int c) { const int st = (r >> 4) * 2 + (c >> 5), rr = r & 15, cc = c & 31, ob = rr * 64 + cc * 2; return st * 1024 + (ob ^ (((ob >> 9) & 1) << 5)); }
__host__ __device__ __forceinline__ void stage_rc(int b, int& R, int& C) { const int st = b / 1024, sb = b % 1024, swz = sb ^ (((sb >> 9) & 1) << 5); R = (st >> 1) * 16 + swz / 64; C = (st & 1) * 32 + (swz % 64) / 2; }
__host__ __device__ __forceinline__ int perm32(int rho) { const int n = rho >> 4, i = rho & 15; return 8 * (i >> 2) + 4 * n + (i & 3); }

struct Unit { int pm, pn, ks; };
struct Gemm { const bf16_t* A; const bf16_t* Bt; int M, N, K, lda; size_t ksA, ksB; };

struct StaticOrder {
    int nM, nN, nwg, G, c;
    __device__ void init(int M, int N, int G_, int c_) { nM = M / BM; nN = N / BM; nwg = nM * nN; G = G_; c = c_; }
    __device__ bool next(int i, Unit& u) const {
        const long Lx = (long)i * G + c; if (Lx >= nwg) return false;
        int wgid = (int)Lx; { const int q = nwg / NXCD, r = nwg % NXCD, xcd = wgid % NXCD, off = wgid / NXCD; wgid = (xcd < r ? xcd * (q + 1) : r * (q + 1) + (xcd - r) * q) + off; }
        const int nig = WGM * nN, gid = wgid / nig, fm = gid * WGM, gsz = (nM - fm) < WGM ? (nM - fm) : WGM;
        u.pm = fm + ((wgid % nig) % gsz); u.pn = (wgid % nig) / gsz; u.ks = 0; return true;
    }
};
struct TwoPassOrder {
    int ntile, nN, G, c;
    __device__ void init(int M, int N, int G_, int c_) { nN = N / BM; ntile = (M / BM) * nN; G = G_; c = c_; }
    __device__ bool next(int i, Unit& u) const {
        const int cc = (G % 8 == 0) ? (c % 8) * (G / 8) + c / 8 : c;
        const int tl = (i >> 1) * G + cc; if (tl >= ntile) return false;
        u.pm = tl / nN; u.pn = tl % nN; u.ks = i & 1; return true;
    }
};

template <class Epi, class Sched>
__device__ __forceinline__ void gemm_phase(LAS unsigned char* lds, const Gemm g, const Sched& S, const Epi& E) {
    const int tid = threadIdx.x, wid = __builtin_amdgcn_readfirstlane(tid >> 6), lane = tid & 63, wr = wid >> 2, wc = wid & 3, fr = lane & 15, fq = lane >> 4;
    const int K = g.K, nt = K / BK;
    unsigned voffA[2], voffB[2];
#pragma unroll
    for (int i = 0; i < 2; ++i) { int R, C; stage_rc(tid * 16 + i * 8192, R, C); const int Rb = (R & ~31) + perm32(R & 31);
        voffA[i] = (unsigned)(R * g.lda + C) * 2u; voffB[i] = (unsigned)(Rb * K + C) * 2u; }
    const size_t kstep = (size_t)(BK * 2);
    const size_t hstepA = (size_t)HALF * g.lda * 2, hstepB = (size_t)HALF * K * 2;
    const size_t tstepA = 2 * hstepA, tstepB = 2 * hstepB;
    const unsigned ldsw = (unsigned)wid * 1024u;
    const int aoff = lds_byte(wr * 64 + fr, fq * 8), boff = lds_byte(wc * 32 + fr, fq * 8);
#define PG8_SA(b, h) (((b) * 2 + (h)) * HTB)
#define PG8_SB(b, h) ((4 + (b) * 2 + (h)) * HTB)
#define PG8_STAGE(bufoff, gbase, voff) do { _Pragma("unroll") for (int _i = 0; _i < 2; ++_i) \
        __builtin_amdgcn_global_load_lds((const unsigned*)((const char*)(gbase) + (voff)[_i]), (LAS unsigned*)(lds + (bufoff) + ldsw + _i * 8192), 16, 0, 0); } while (0)
#define PG8_LDA(dst, b, h) do { _Pragma("unroll") for (int m = 0; m < 4; ++m) _Pragma("unroll") for (int k = 0; k < 2; ++k) dst[m][k] = *(const LAS bf16x8*)(lds + PG8_SA(b, h) + aoff + m * 2048 + k * 1024); } while (0)
#define PG8_LDB(dst, b, h) do { _Pragma("unroll") for (int n = 0; n < 2; ++n) _Pragma("unroll") for (int k = 0; k < 2; ++k) dst[n][k] = *(const LAS bf16x8*)(lds + PG8_SB(b, h) + boff + n * 2048 + k * 1024); } while (0)
#define PG8_MMA(ai, bj, At, Bt) do { __builtin_amdgcn_s_setprio(1); _Pragma("unroll") for (int m = 0; m < 4; ++m) _Pragma("unroll") for (int n = 0; n < 2; ++n) _Pragma("unroll") for (int k = 0; k < 2; ++k) \
        acc[ai][bj][m][n] = __builtin_amdgcn_mfma_f32_16x16x32_bf16(Bt[n][k], At[m][k], acc[ai][bj][m][n], 0, 0, 0); __builtin_amdgcn_s_setprio(0); } while (0)
#define PG8_WAIT_V(n) asm volatile("s_waitcnt vmcnt(" #n ")" ::: "memory")
#define PG8_WAIT_L(n) asm volatile("s_waitcnt lgkmcnt(" #n ")" ::: "memory")
#define PG8_BAR __builtin_amdgcn_s_barrier()
#define PG8_SCHED __builtin_amdgcn_sched_barrier(0)
    Unit cur, nxt; int ui = 0;
    if (!S.next(0, cur)) return;
    f32x4 acc[2][2][4][2];
#pragma unroll
    for (int a = 0; a < 2; ++a)
#pragma unroll
        for (int b = 0; b < 2; ++b)
#pragma unroll
            for (int m = 0; m < 4; ++m)
#pragma unroll
                for (int n = 0; n < 2; ++n) acc[a][b][m][n] = (f32x4){0.f, 0.f, 0.f, 0.f};
    bf16x8 At[4][2], B0[2][2], B1[2][2];
    const char* cA = (const char*)g.A + (size_t)cur.pm * tstepA + (size_t)cur.ks * g.ksA; const char* cB = (const char*)g.Bt + (size_t)cur.pn * tstepB + (size_t)cur.ks * g.ksB;
    PG8_STAGE(PG8_SB(0, 0), cB, voffB); PG8_STAGE(PG8_SB(0, 1), cB + hstepB, voffB); PG8_STAGE(PG8_SA(0, 0), cA, voffA); PG8_STAGE(PG8_SA(0, 1), cA + hstepA, voffA);
    if (wr == 1) PG8_BAR;
    PG8_WAIT_V(2); PG8_BAR;
    PG8_STAGE(PG8_SB(1, 0), cB + kstep, voffB); PG8_STAGE(PG8_SA(1, 0), cA + kstep, voffA); PG8_STAGE(PG8_SB(1, 1), cB + hstepB + kstep, voffB);
    PG8_WAIT_V(6); PG8_BAR;
    for (;;) {
        const bool has_next = S.next(ui + 1, nxt);
        const char* nA = has_next ? (const char*)g.A + (size_t)nxt.pm * tstepA + (size_t)nxt.ks * g.ksA : cA; const char* nB = has_next ? (const char*)g.Bt + (size_t)nxt.pn * tstepB + (size_t)nxt.ks * g.ksB : cB;
        for (int t = 0; t < nt; t += 2) {
            const bool last = (t == nt - 2);
            const char* a1 = cA + (size_t)(t + 1) * kstep;
            const char* a2 = last ? nA : cA + (size_t)(t + 2) * kstep; const char* b2 = last ? nB : cB + (size_t)(t + 2) * kstep;
            const char* a3 = a2 + kstep; const char* b3 = b2 + kstep;
            PG8_LDB(B0, 0, 0); PG8_LDB(B1, 0, 1); PG8_SCHED; PG8_LDA(At, 0, 0); PG8_STAGE(PG8_SA(1, 1), a1 + hstepA, voffA);
            PG8_WAIT_V(8); PG8_WAIT_L(0); PG8_BAR; PG8_MMA(0, 0, At, B0); PG8_MMA(0, 1, At, B1); PG8_BAR; PG8_SCHED;
            PG8_LDA(At, 0, 1); PG8_STAGE(PG8_SB(0, 0), b2, voffB); PG8_STAGE(PG8_SB(0, 1), b2 + hstepB, voffB); PG8_STAGE(PG8_SA(0, 0), a2, voffA);
            PG8_WAIT_V(8); PG8_WAIT_L(0); PG8_BAR; PG8_MMA(1, 0, At, B0); PG8_MMA(1, 1, At, B1); PG8_BAR; PG8_SCHED;
            PG8_LDB(B0, 1, 0); PG8_LDB(B1, 1, 1); PG8_SCHED; PG8_LDA(At, 1, 0); PG8_STAGE(PG8_SA(0, 1), a2 + hstepA, voffA);
            PG8_WAIT_V(8); PG8_WAIT_L(0); PG8_BAR; PG8_MMA(0, 0, At, B0); PG8_MMA(0, 1, At, B1); PG8_BAR; PG8_SCHED;
            PG8_LDA(At, 1, 1); PG8_STAGE(PG8_SB(1, 0), b3, voffB); PG8_STAGE(PG8_SB(1, 1), b3 + hstepB, voffB); PG8_STAGE(PG8_SA(1, 0), a3, voffA);
            PG8_WAIT_V(8); PG8_WAIT_L(0); PG8_BAR; PG8_MMA(1, 0, At, B0); PG8_MMA(1, 1, At, B1); PG8_BAR; PG8_SCHED;
        }
        if (wr == 0) PG8_BAR;
        E(acc, cur, wr, wc, fr, fq);
        if (!has_next) break;
#pragma unroll
        for (int a = 0; a < 2; ++a)
#pragma unroll
            for (int b = 0; b < 2; ++b)
#pragma unroll
                for (int m = 0; m < 4; ++m)
#pragma unroll
                    for (int n = 0; n < 2; ++n) acc[a][b][m][n] = (f32x4){0.f, 0.f, 0.f, 0.f};
        cur = nxt; cA = nA; cB = nB; ++ui;
        if (wr == 1) PG8_BAR;
    }
    PG8_WAIT_V(0);
    PG8_BAR;
#undef PG8_SA
#undef PG8_SB
#undef PG8_STAGE
#undef PG8_LDA
#undef PG8_LDB
#undef PG8_MMA
#undef PG8_WAIT_V
#undef PG8_WAIT_L
#undef PG8_BAR
#undef PG8_SCHED
}

__device__ __forceinline__ u32x4 pack8(const f32x4 v0, const f32x4 v1) { u32x4 w; w.x = cvt_pk_bf16(v0[0], v0[1]); w.y = cvt_pk_bf16(v0[2], v0[3]); w.z = cvt_pk_bf16(v1[0], v1[1]); w.w = cvt_pk_bf16(v1[2], v1[3]); return w; }
__device__ __forceinline__ void unpack8(const u32x4 w, f32x4& v0, f32x4& v1) { v0 = (f32x4){bf_lo(w.x), bf_hi(w.x), bf_lo(w.y), bf_hi(w.y)}; v1 = (f32x4){bf_lo(w.z), bf_hi(w.z), bf_lo(w.w), bf_hi(w.w)}; }

struct EpiQKV {
    bf16_t* rawqk; bf16_t* vbuf;
    __device__ __forceinline__ void operator()(const f32x4 (&acc)[2][2][4][2], const Unit& u, int wr, int wc, int fr, int fq) const {
        int colt = u.pn * BM; bf16_t* base = rawqk; if (colt >= 2048) { base = vbuf; colt -= 2048; }
        const int row0 = 64 + u.pm * BM + wr * 64 + fr, col0 = colt + wc * 32 + 8 * fq;
#pragma unroll
        for (int ai = 0; ai < 2; ++ai)
#pragma unroll
            for (int m = 0; m < 4; ++m) { bf16_t* rowp = base + (size_t)(row0 + ai * HALF + m * 16) * 2048 + col0;
#pragma unroll
                for (int bj = 0; bj < 2; ++bj) *(u32x4*)(rowp + bj * HALF) = pack8(acc[ai][bj][m][0], acc[ai][bj][m][1]); }
    }
};

struct EpiGate {
    bf16_t* H; bf16_t* G2; const float* hss; const float* mg; const float* gg;
    __device__ __forceinline__ void operator()(const f32x4 (&acc)[2][2][4][2], const Unit& u, int wr, int wc, int fr, int fq) const {
        const int row0 = u.pm * BM + wr * 64 + fr;
        if (u.pn >= 8) {
            const int col0 = (u.pn - 8) * BM + wc * 32 + 8 * fq;
#pragma unroll
            for (int ai = 0; ai < 2; ++ai)
#pragma unroll
                for (int m = 0; m < 4; ++m) { bf16_t* rowp = G2 + (size_t)(row0 + ai * HALF + m * 16) * 2048 + col0;
#pragma unroll
                    for (int bj = 0; bj < 2; ++bj) { f32x4 v0 = acc[ai][bj][m][0], v1 = acc[ai][bj][m][1];
#pragma unroll
                        for (int e = 0; e < 4; ++e) { v0[e] = sigmoidf_(v0[e]); v1[e] = sigmoidf_(v1[e]); }
                        *(u32x4*)(rowp + bj * HALF) = pack8(v0, v1); } }
        } else {
            const int br = u.pn >> 2, head = u.pn & 3;
            const float* gain = (br ? gg : mg) + head * 256 + wc * 32 + 8 * fq;
            f32x4 gv[2][2];
#pragma unroll
            for (int bj = 0; bj < 2; ++bj) { gv[bj][0] = *(const f32x4*)(gain + bj * HALF); gv[bj][1] = *(const f32x4*)(gain + bj * HALF + 4); }
            const int col0 = br * 1024 + head * 256 + wc * 32 + 8 * fq;
#pragma unroll
            for (int ai = 0; ai < 2; ++ai) {
                float rs4[4];
                {   f32x4 sa[4], sb[4];
#pragma unroll
                    for (int m = 0; m < 4; ++m) { const int row = row0 + ai * HALF + m * 16;
                        sa[m] = *(const f32x4*)(hss + (size_t)row * 64 + br * 32 + head * 8); sb[m] = *(const f32x4*)(hss + (size_t)row * 64 + br * 32 + head * 8 + 4); }
#pragma unroll
                    for (int m = 0; m < 4; ++m) { const f32x4 s0 = sa[m], s1 = sb[m];
                        const float ssum = ((s0[0] + s0[1]) + (s0[2] + s0[3])) + ((s1[0] + s1[1]) + (s1[2] + s1[3]));
                        rs4[m] = __builtin_amdgcn_rsqf(ssum * (1.f / 256.f) + EPS); } }
                u32x4 hraw[4][2];
#pragma unroll
                for (int m = 0; m < 4; ++m)
#pragma unroll
                    for (int bj = 0; bj < 2; ++bj) hraw[m][bj] = *(const u32x4*)(H + (size_t)(row0 + ai * HALF + m * 16) * 2048 + col0 + bj * HALF);
#pragma unroll
                for (int m = 0; m < 4; ++m) { const int row = row0 + ai * HALF + m * 16;
                    const float rstd = rs4[m];
                    bf16_t* rowp = H + (size_t)row * 2048 + col0;
#pragma unroll
                    for (int bj = 0; bj < 2; ++bj) { f32x4 a0 = acc[ai][bj][m][0], a1 = acc[ai][bj][m][1], h0, h1;
                        unpack8(hraw[m][bj], h0, h1);
#pragma unroll
                        for (int e = 0; e < 4; ++e) { const float g0 = br ? siluf_(a0[e]) : sigmoidf_(a0[e]), g1 = br ? siluf_(a1[e]) : sigmoidf_(a1[e]);
                            h0[e] = h0[e] * rstd * gv[bj][0][e] * g0; h1[e] = h1[e] * rstd * gv[bj][1][e] * g1; }
                        *(u32x4*)(rowp + bj * HALF) = pack8(h0, h1); } } }
        }
    }
};

struct EpiMerge {
    bf16_t* MG; const bf16_t* G2;
    __device__ __forceinline__ void operator()(const f32x4 (&acc)[2][2][4][2], const Unit& u, int wr, int wc, int fr, int fq) const {
        const int row0 = u.pm * BM + wr * 64 + fr, col0 = u.pn * BM + wc * 32 + 8 * fq;
#pragma unroll
        for (int ai = 0; ai < 2; ++ai) {
            u32x4 gr[4][2], pr[4][2];
#pragma unroll
            for (int m = 0; m < 4; ++m)
#pragma unroll
                for (int bj = 0; bj < 2; ++bj) { const int row = row0 + ai * HALF + m * 16;
                    gr[m][bj] = *(const u32x4*)(G2 + (size_t)row * 2048 + u.ks * 1024 + col0 + bj * HALF);
                    pr[m][bj] = u.ks ? *(const u32x4*)(MG + (size_t)row * 1024 + col0 + bj * HALF) : (u32x4){0u, 0u, 0u, 0u}; }
#pragma unroll
            for (int m = 0; m < 4; ++m) { const int row = row0 + ai * HALF + m * 16; bf16_t* rowp = MG + (size_t)row * 1024 + col0;
#pragma unroll
                for (int bj = 0; bj < 2; ++bj) { f32x4 g0, g1, p0, p1; unpack8(gr[m][bj], g0, g1); unpack8(pr[m][bj], p0, p1);
                    *(u32x4*)(rowp + bj * HALF) = pack8(acc[ai][bj][m][0] * g0 + p0, acc[ai][bj][m][1] * g1 + p1); } } }
    }
};

struct EpiResid {
    const float* resid; bf16_t* h1b; float* sumsq;
    __device__ __forceinline__ void operator()(const f32x4 (&acc)[2][2][4][2], const Unit& u, int wr, int wc, int fr, int fq) const {
        const int row0 = u.pm * BM + wr * 64 + fr, col0 = u.pn * BM + wc * 32 + 8 * fq;
#pragma unroll
        for (int ai = 0; ai < 2; ++ai) {
            f32x4 rv[4][2][2];
#pragma unroll
            for (int m = 0; m < 4; ++m)
#pragma unroll
                for (int bj = 0; bj < 2; ++bj) { const size_t o = (size_t)(row0 + ai * HALF + m * 16) * 1024 + col0 + bj * HALF; rv[m][bj][0] = *(const f32x4*)(resid + o); rv[m][bj][1] = *(const f32x4*)(resid + o + 4); }
#pragma unroll
            for (int m = 0; m < 4; ++m) { const int row = row0 + ai * HALF + m * 16; float ss = 0.f;
#pragma unroll
                for (int bj = 0; bj < 2; ++bj) { const size_t o = (size_t)row * 1024 + col0 + bj * HALF;
                    const f32x4 v0 = rv[m][bj][0] + acc[ai][bj][m][0], v1 = rv[m][bj][1] + acc[ai][bj][m][1];
                    ss += (v0[0] * v0[0] + v0[1] * v0[1]) + (v0[2] * v0[2] + v0[3] * v0[3]) + (v1[0] * v1[0] + v1[1] * v1[1]) + (v1[2] * v1[2] + v1[3] * v1[3]);
                    *(u32x4*)(h1b + o) = pack8(v0, v1); }
                ss += __shfl_xor(ss, 16); ss += __shfl_xor(ss, 32);
                if (fq == 0) __hip_atomic_fetch_add(sumsq + row, ss, __ATOMIC_RELAXED, __HIP_MEMORY_SCOPE_AGENT); } }
    }
};

struct EpiFF {
    bf16_t* FF; const float* sumsq;
    __device__ __forceinline__ void operator()(const f32x4 (&acc)[2][2][4][2], const Unit& u, int wr, int wc, int fr, int fq) const {
        const int row0 = u.pm * BM + wr * 64 + fr, col0 = u.pn * HALF + wc * 32 + 8 * fq;
        float ssq[2][4];
#pragma unroll
        for (int ai = 0; ai < 2; ++ai)
#pragma unroll
            for (int m = 0; m < 4; ++m) ssq[ai][m] = sumsq[row0 + ai * HALF + m * 16];
#pragma unroll
        for (int ai = 0; ai < 2; ++ai)
#pragma unroll
            for (int m = 0; m < 4; ++m) { const int row = row0 + ai * HALF + m * 16;
                const float r = __builtin_amdgcn_rsqf(ssq[ai][m] * (1.f / 1024.f) + EPS);
                f32x4 v0, v1;
#pragma unroll
                for (int e = 0; e < 4; ++e) { v0[e] = siluf_(r * acc[ai][0][m][0][e]) * (r * acc[ai][1][m][0][e]); v1[e] = siluf_(r * acc[ai][0][m][1][e]) * (r * acc[ai][1][m][1][e]); }
                *(u32x4*)(FF + (size_t)row * DFF + col0) = pack8(v0, v1); }
    }
};

struct EpiFinal {
    float* out; const bf16_t* h1b; const float* fg; float* sumsq; unsigned* cnt;
    __device__ __forceinline__ void operator()(f32x4 (&acc)[2][2][4][2], const Unit& u, int wr, int wc, int fr, int fq) const {
        const int row0 = u.pm * BM + wr * 64 + fr, col0 = u.pn * BM + wc * 32 + 8 * fq;
#pragma unroll
        for (int ai = 0; ai < 2; ++ai) {
            u32x4 hb[4][2];
#pragma unroll
            for (int m = 0; m < 4; ++m)
#pragma unroll
                for (int bj = 0; bj < 2; ++bj) hb[m][bj] = *(const u32x4*)(h1b + (size_t)(row0 + ai * HALF + m * 16) * 1024 + col0 + bj * HALF);
#pragma unroll
            for (int m = 0; m < 4; ++m) { const int row = row0 + ai * HALF + m * 16; float ss = 0.f;
#pragma unroll
                for (int bj = 0; bj < 2; ++bj) { const size_t o = (size_t)row * 1024 + col0 + bj * HALF;
                    f32x4 r0, r1; unpack8(hb[m][bj], r0, r1);
                    const f32x4 v0 = r0 + acc[ai][bj][m][0], v1 = r1 + acc[ai][bj][m][1];
                    acc[ai][bj][m][0] = v0; acc[ai][bj][m][1] = v1;
                    ss += (v0[0] * v0[0] + v0[1] * v0[1]) + (v0[2] * v0[2] + v0[3] * v0[3]) + (v1[0] * v1[0] + v1[1] * v1[1]) + (v1[2] * v1[2] + v1[3] * v1[3]); }
                ss += __shfl_xor(ss, 16); ss += __shfl_xor(ss, 32);
                if (fq == 0) __hip_atomic_fetch_add(sumsq + row, ss, __ATOMIC_RELAXED, __HIP_MEMORY_SCOPE_AGENT); } }
        asm volatile("s_waitcnt vmcnt(0)" ::: "memory");
        __syncthreads();
        if (threadIdx.x == 0) {
            __threadfence();
            unsigned* c = cnt + u.pm * 64;
            __hip_atomic_fetch_add(c, 1u, __ATOMIC_RELAXED, __HIP_MEMORY_SCOPE_AGENT);
            unsigned sp = 0;
            while (__hip_atomic_load(c, __ATOMIC_RELAXED, __HIP_MEMORY_SCOPE_AGENT) < 4u) { __builtin_amdgcn_s_sleep(1); if (++sp > (1u << 22)) break; }
            __threadfence();
        }
        __syncthreads();
        f32x4 gv[2][2];
#pragma unroll
        for (int bj = 0; bj < 2; ++bj) { gv[bj][0] = *(const f32x4*)(fg + col0 + bj * HALF); gv[bj][1] = *(const f32x4*)(fg + col0 + bj * HALF + 4); }
        float ssv[2][4];
#pragma unroll
        for (int ai = 0; ai < 2; ++ai)
#pragma unroll
            for (int m = 0; m < 4; ++m) ssv[ai][m] = __hip_atomic_load(sumsq + row0 + ai * HALF + m * 16, __ATOMIC_RELAXED, __HIP_MEMORY_SCOPE_AGENT);
#pragma unroll
        for (int ai = 0; ai < 2; ++ai)
#pragma unroll
            for (int m = 0; m < 4; ++m) { const int row = row0 + ai * HALF + m * 16;
                const float rs = __builtin_amdgcn_rsqf(ssv[ai][m] * (1.f / 1024.f) + EPS);
#pragma unroll
                for (int bj = 0; bj < 2; ++bj) { const size_t o = (size_t)row * 1024 + col0 + bj * HALF;
                    *(f32x4*)(out + o) = acc[ai][bj][m][0] * rs * gv[bj][0]; *(f32x4*)(out + o + 4) = acc[ai][bj][m][1] * rs * gv[bj][1]; } }
    }
};
}


#define XB_TMO      128
#define XB_XCNT(j)  (256  + 64 * (j))
#define XB_XSUB(j)  (1280 + 64 * (j))
#define XB_XGEN(j)  (2304 + 64 * (j))
#define XB_TOP      3328
#define XB_TOPGEN   3392
#define XCD_BAR_WORDS 3456
#define XB_SPIN_CAP (1u << 18)
__device__ __forceinline__ unsigned xb_ld(unsigned* p)              { return __hip_atomic_load(p, __ATOMIC_RELAXED, __HIP_MEMORY_SCOPE_AGENT); }
__device__ __forceinline__ unsigned xb_add(unsigned* p, unsigned v) { return __hip_atomic_fetch_add(p, v, __ATOMIC_RELAXED, __HIP_MEMORY_SCOPE_AGENT); }
__device__ __forceinline__ unsigned xb_xcc_id() { return (unsigned)__builtin_amdgcn_s_getreg((3 << 11) | 20) & 0xFu; }
#define XB_SPIN(cond, bar) do { unsigned _sp = 0; while (cond) { __builtin_amdgcn_s_sleep(1); \
    if ((++_sp & 255u) == 0u) { if (xb_ld(&(bar)[XB_TMO])) break; if (_sp > XB_SPIN_CAP) { atomicAdd(&(bar)[XB_TMO], 1u); break; } } } } while (0)
struct XcdBarrier { unsigned* bar; unsigned x; volatile LAS unsigned* st; };
__device__ __forceinline__ XcdBarrier xcd_barrier_post(unsigned* bar, volatile LAS unsigned* st) {
    XcdBarrier b; b.bar = bar; b.x = xb_xcc_id(); b.st = st;
    if (threadIdx.x == 0) (void)xb_add(&bar[XB_XCNT(b.x)], 1u);
    return b;
}
__device__ __forceinline__ void xcd_barrier_complete(unsigned* bar, unsigned x, unsigned& nloc, unsigned& nx) {
    const unsigned G = gridDim.x * gridDim.y * gridDim.z;
    unsigned sum, cnt, mine, sp = 0u;
    for (;;) {
        sum = 0u; cnt = 0u; mine = 0u;
#pragma unroll
        for (unsigned j = 0; j < 16; ++j) { const unsigned c = xb_ld(&bar[XB_XCNT(j)]); sum += c; cnt += (c > 0u) ? 1u : 0u; mine = (j == x) ? c : mine; }
        if (sum == G) break;
        __builtin_amdgcn_s_sleep(1);
        if ((++sp & 255u) == 0u) { if (xb_ld(&bar[XB_TMO])) break; if (sp > XB_SPIN_CAP) { atomicAdd(&bar[XB_TMO], 1u); break; } }
    }
    nloc = mine > 0u ? mine : 1u; nx = cnt > 0u ? cnt : 1u;
}
__device__ __forceinline__ void xcd_barrier(const XcdBarrier& b) {
    asm volatile("s_waitcnt vmcnt(0)" ::: "memory");
    __syncthreads();
    if (threadIdx.x == 0) {
        unsigned* bar = b.bar;
        __builtin_amdgcn_s_waitcnt(0);
        unsigned nloc = b.st[0], nx = b.st[1];
        if (nloc == 0u) { xcd_barrier_complete(bar, b.x, nloc, nx); b.st[0] = nloc; b.st[1] = nx; }
        const unsigned old = xb_add(&bar[XB_XSUB(b.x)], 1u);
        const unsigned gen = old / nloc;
        if (old + 1u == (gen + 1u) * nloc) {
            __builtin_amdgcn_fence(__ATOMIC_RELEASE, "agent");
            asm volatile("s_waitcnt vmcnt(0)" ::: "memory");
            const unsigned og = xb_add(&bar[XB_TOP], 1u);
            const unsigned tg = og / nx;
            if (og + 1u == (tg + 1u) * nx) xb_add(&bar[XB_TOPGEN], 1u);
            else XB_SPIN(xb_ld(&bar[XB_TOPGEN]) == tg, bar);
            __builtin_amdgcn_fence(__ATOMIC_ACQUIRE, "agent");
            xb_add(&bar[XB_XGEN(b.x)], 1u);
            asm volatile("s_waitcnt vmcnt(0)" ::: "memory");
        } else {
            XB_SPIN(xb_ld(&bar[XB_XGEN(b.x)]) == gen, bar);
            __builtin_amdgcn_fence(__ATOMIC_ACQUIRE, "agent");
            asm volatile("s_waitcnt vmcnt(0)" ::: "memory");
        }
    }
    __syncthreads();
}

struct Params { const float* in[19]; float* out; unsigned char* ws; int ph_lo, ph_hi; };

__device__ __forceinline__ void transpose_item(const float* W, int ldw, int K, bf16_t* WT, int kb, int nb, LAS float* scr, int lane, const float* ksc) {
    const int k0 = 64 * kb, n0 = 32 * nb;
    const float* Wl = W + (size_t)(k0 + (lane >> 5)) * ldw + n0 + (lane & 31);
#pragma unroll
    for (int hh = 0; hh < 2; ++hh) { float tv[16];
#pragma unroll
        for (int i = 0; i < 16; ++i) tv[i] = Wl[(size_t)(2 * (16 * hh + i)) * ldw];
        if (ksc) {
#pragma unroll
            for (int i = 0; i < 16; ++i) tv[i] *= ksc[k0 + 2 * (16 * hh + i) + (lane >> 5)]; }
#pragma unroll
        for (int i = 0; i < 16; ++i) { const int kk = 2 * (16 * hh + i) + (lane >> 5); scr[kk * 33 + (lane & 31)] = tv[i]; } }
    asm volatile("s_waitcnt lgkmcnt(0)" ::: "memory");
    const int c = lane & 7;
#pragma unroll
    for (int j = 0; j < 4; ++j) { const int n = (lane >> 3) + 8 * j; const LAS float* s = scr + (8 * c) * 33 + n;
        u32x4 o; o.x = cvt_pk_bf16(s[0 * 33], s[1 * 33]); o.y = cvt_pk_bf16(s[2 * 33], s[3 * 33]); o.z = cvt_pk_bf16(s[4 * 33], s[5 * 33]); o.w = cvt_pk_bf16(s[6 * 33], s[7 * 33]);
        *(u32x4*)(WT + (size_t)(n0 + n) * K + k0 + 8 * c) = o; }
    asm volatile("s_waitcnt lgkmcnt(0)" ::: "memory");
}

__device__ __forceinline__ void p0_prologue(const Params& p, LAS unsigned char* L) {
    const int tid = threadIdx.x, lane = tid & 63, wave = __builtin_amdgcn_readfirstlane(tid >> 6);
    const int G = gridDim.x, gw = blockIdx.x * 8 + wave, NGW = G * 8;
    unsigned char* ws = p.ws;
    const float* w_in = p.in[3];
    {
        LAS float* scr = (LAS float*)(L + wave * 8448);
        constexpr int NITEMS = 3072 + 1024 + 1536 + 2816 + 1408;
        for (int it = gw; it < NITEMS; it += NGW) {
            int r = it; const float* src; int ldw, K = 1024, kb, nb; bf16_t* dst; const float* ksc = nullptr;
            if (r < 3072) { const int pc = r >> 9; r &= 511; kb = r >> 5; nb = r & 31; ldw = NPROJ;
                const int so = pc == 0 ? 0 : pc == 1 ? 3080 : pc == 2 ? 1024 : pc == 3 ? 4104 : pc == 4 ? 2056 : 5144;
                src = w_in + so; dst = (bf16_t*)(ws + (pc < 4 ? WS_WTA : WS_WTB)) + (size_t)(pc < 4 ? pc : pc - 4) * 1048576; }
            else if ((r -= 3072) < 1024) { kb = r >> 6; nb = r & 63; ldw = NPROJ; src = w_in + 6168; dst = (bf16_t*)(ws + WS_WTB) + (size_t)2 * 1048576; }
            else if ((r -= 1024) < 1536) { const int pc = r >> 9; r &= 511; kb = r >> 5; nb = r & 31; ldw = 1024; src = p.in[11 + pc]; dst = (bf16_t*)(ws + WS_WTBM) + (size_t)pc * 1048576; }
            else if ((r -= 1536) < 2816) { const int q = r >> 6; r &= 63; kb = r >> 2; nb = r & 3; const int i = q >> 1, isup = q & 1; ldw = DFF;
                src = p.in[15 + isup] + 128 * i; dst = (bf16_t*)(ws + WS_WTFF) + (size_t)(256 * i + 128 * isup) * 1024; ksc = p.in[14]; }
            else { r -= 2816; kb = r >> 5; nb = r & 31; ldw = 1024; K = DFF; src = p.in[17]; dst = (bf16_t*)(ws + WS_WTD); }
            transpose_item(src, ldw, K, dst, kb, nb, scr, lane, ksc);
        }
    }
    __syncthreads();
    {
        LAS float* xT = (LAS float*)L;
        LAS float* red = (LAS float*)(L + 65536);
#pragma unroll
        for (int rr = 0; rr < 2; ++rr) { const int row = 2 * wave + rr; const f32x4* xr = (const f32x4*)(p.in[1] + (size_t)row * 1024) + lane; const f32x4* gr = (const f32x4*)p.in[2] + lane;
            f32x4 v[4]; float s = 0.f;
#pragma unroll
            for (int j = 0; j < 4; ++j) { v[j] = xr[64 * j]; s += (v[j][0] * v[j][0] + v[j][1] * v[j][1]) + (v[j][2] * v[j][2] + v[j][3] * v[j][3]); }
            const float rstd = __builtin_amdgcn_rsqf(wave_sum(s) * (1.f / 1024.f) + EPS);
#pragma unroll
            for (int j = 0; j < 4; ++j) { const f32x4 gq = gr[64 * j];
#pragma unroll
                for (int e = 0; e < 4; ++e) xT[(256 * j + 4 * lane + e) * 16 + row] = v[j][e] * rstd * gq[e]; } }
        __syncthreads();
        for (int cg0 = blockIdx.x * 16; cg0 < 4096; cg0 += G * 16) {
            const int ci = lane & 15, kq = lane >> 4, dcol = cg0 + ci;
            const int scol = dcol < 1024 ? dcol : dcol < 2048 ? 3080 + (dcol - 1024) : dcol < 3072 ? 1024 + (dcol - 2048) : 4104 + (dcol - 3072);
            float a[16];
#pragma unroll
            for (int r = 0; r < 16; ++r) a[r] = 0.f;
            const int kbase = 128 * wave + kq;
            const float* wp = w_in + (size_t)kbase * NPROJ + scol;
#pragma unroll
            for (int ib = 0; ib < 2; ++ib) { float wv[16];
#pragma unroll
                for (int i = 0; i < 16; ++i) wv[i] = wp[(size_t)(4 * (16 * ib + i)) * NPROJ];
#pragma unroll
                for (int i = 0; i < 16; ++i) { const LAS f32x4* xp = (const LAS f32x4*)(xT + (kbase + 4 * (16 * ib + i)) * 16);
#pragma unroll
                    for (int q = 0; q < 4; ++q) { const f32x4 xv = xp[q];
#pragma unroll
                        for (int e = 0; e < 4; ++e) a[4 * q + e] += xv[e] * wv[i]; }
                    __builtin_amdgcn_sched_barrier(0); } }
#pragma unroll
            for (int r = 0; r < 16; ++r) { a[r] += __shfl_xor(a[r], 16); a[r] += __shfl_xor(a[r], 32); }
            if (kq == 0) {
#pragma unroll
                for (int r = 0; r < 16; ++r) red[(wave * 16 + r) * 16 + ci] = a[r]; }
            __syncthreads();
            if (tid < 256) { const int row = tid >> 4, cc = tid & 15, dc = cg0 + cc; float sm = 0.f;
#pragma unroll
                for (int w = 0; w < 8; ++w) sm += red[(w * 16 + row) * 16 + cc];
                bf16_t* dst = dc < 2048 ? (bf16_t*)(ws + WS_R1) + (size_t)(48 + row) * 2048 + dc : (bf16_t*)(ws + WS_R2) + (size_t)(48 + row) * 2048 + (dc - 2048);
                *dst = f2bf(sm); }
            __syncthreads();
        }
    }
    {
        LAS float* Wsm = (LAS float*)L;
#pragma unroll
        for (int b0 = 0; b0 < 48; b0 += 16) { float tv[16];
#pragma unroll
            for (int i = 0; i < 16; ++i) { const int idx = tid + 512 * (b0 + i); const int k = idx / 24, c = idx - k * 24; const int sc = c < 8 ? 2048 + c : 5128 + (c - 8); tv[i] = w_in[(size_t)k * NPROJ + sc]; }
#pragma unroll
            for (int i = 0; i < 16; ++i) { const int idx = tid + 512 * (b0 + i); const int k = idx / 24, c = idx - k * 24; Wsm[c * 1028 + k] = tv[i]; } }
        __syncthreads();
        float* GI = (float*)(ws + WS_GI); float* GF = (float*)(ws + WS_GF); float* GA = (float*)(ws + WS_GA);
        bf16_t* XN = (bf16_t*)((unsigned char*)p.out + OUT_XN);
        const float bsel = lane < 8 ? p.in[6][lane] : 0.f;
        const f32x4* gr = (const f32x4*)p.in[2] + lane;
        f32x4 g1v[4];
#pragma unroll
        for (int j = 0; j < 4; ++j) g1v[j] = gr[64 * j];
        f32x4 vn[4];
        { const int r = gw; const f32x4* xr = (const f32x4*)(r >= SEQ ? p.in[1] + (size_t)(r - SEQ) * 1024 : p.in[0] + (size_t)r * 1024) + lane;
#pragma unroll
            for (int j = 0; j < 4; ++j) vn[j] = (r < SEQ + 16) ? xr[64 * j] : (f32x4){0.f, 0.f, 0.f, 0.f}; }
        for (int r = gw; r < SEQ + 16; r += NGW) {
            const bool ismeta = r >= SEQ; const int t = ismeta ? 48 + (r - SEQ) : 64 + r;
            f32x4 v[4]; float s = 0.f;
#pragma unroll
            for (int j = 0; j < 4; ++j) { v[j] = vn[j]; s += (v[j][0] * v[j][0] + v[j][1] * v[j][1]) + (v[j][2] * v[j][2] + v[j][3] * v[j][3]); }
            { const int r2 = r + NGW; if (r2 < SEQ + 16) { const f32x4* xr = (const f32x4*)(r2 >= SEQ ? p.in[1] + (size_t)(r2 - SEQ) * 1024 : p.in[0] + (size_t)r2 * 1024) + lane;
#pragma unroll
                for (int j = 0; j < 4; ++j) vn[j] = xr[64 * j]; } }
            const float rstd = __builtin_amdgcn_rsqf(wave_sum(s) * (1.f / 1024.f) + EPS);
#pragma unroll
            for (int j = 0; j < 4; ++j) v[j] = v[j] * rstd * g1v[j];
            if (!ismeta) { u32x2* o8 = (u32x2*)(XN + (size_t)r * 1024) + lane;
#pragma unroll
                for (int j = 0; j < 4; ++j) { u32x2 o; o.x = cvt_pk_bf16(v[j][0], v[j][1]); o.y = cvt_pk_bf16(v[j][2], v[j][3]); o8[64 * j] = o; } }
            float mine = 0.f;
#pragma unroll 4
            for (int c = 0; c < 24; ++c) { float d = 0.f;
#pragma unroll
                for (int j = 0; j < 4; ++j) { const f32x4 wv = *(const LAS f32x4*)(Wsm + c * 1028 + 256 * j + 4 * lane); d += (v[j][0] * wv[0] + v[j][1] * wv[1]) + (v[j][2] * wv[2] + v[j][3] * wv[3]); }
                d = wave_sum(d); if (lane == c) mine = d; }
            if (lane < 4) GI[t * 4 + lane] = mine + bsel;
            else if (lane < 8) GF[t * 4 + lane - 4] = logsigmoidf_(mine + bsel);
            else if (lane < 24) GA[t * 16 + lane - 8] = mine;
        }
    }
}

constexpr int XL_AQ = 0, XL_BK = 17408, XL_KT = 34816, XL_F = 53248;
template <bool SINGLE>
__device__ __forceinline__ void x_phase(const Params& p, LAS unsigned char* L, const int item0, const int NIT, const int GS) {
    const int tid = threadIdx.x, lane = tid & 63, wave = __builtin_amdgcn_readfirstlane(tid >> 6), fr = lane & 15, fq = lane >> 4;
    unsigned char* ws = p.ws;
    const bf16_t* RAW = (const bf16_t*)(ws + WS_R1);
    bf16_t* AQ = (bf16_t*)(ws + WS_AQ); bf16_t* KU = (bf16_t*)(ws + WS_KU); bf16_t* WW = (bf16_t*)((unsigned char*)p.out + OUT_WW);
    const float* GI = (const float*)(ws + WS_GI); const float* GF = (const float*)(ws + WS_GF); const float* GA = (const float*)(ws + WS_GA);
    float* CHB = (float*)(ws + WS_CHB); float* CHM = (float*)(ws + WS_CHM); float* CHG = (float*)(ws + WS_CHG); float* BT = (float*)(ws + WS_BT);
    LAS bf16_t* sAq = (LAS bf16_t*)(L + XL_AQ); LAS bf16_t* sBk = (LAS bf16_t*)(L + XL_BK); LAS bf16_t* sKt = (LAS bf16_t*)(L + XL_KT);
    LAS float* sF = (LAS float*)(L + XL_F);
    LAS float* sga = sF + 256;
    LAS float* part = sF + 256 + 1024;
    const float NINF = -__builtin_inff();
#define X_DECODE(item, c, br, h) const int c = (item) >> 3, br = (((item) >> 2) ^ (c >> 5)) & 1, h = (item) & 3
    const int which = tid >> 8, u = tid & 255, d8 = (u & 15) * 8, l0 = (u >> 4) * 4;
    const int gd = tid & 127, grp = tid >> 7;
    u32x4 raw[7]; float glf = 0.f, gli = 0.f;
    bf16_t rq[16], rk[16]; f32x4 gav = (f32x4){0.f, 0.f, 0.f, 0.f};
#define X_LOAD_M(c, h) do { const int _t0 = (c) * 64; const bf16_t* _src = RAW + which * 512 + (h) * 128 + d8; \
        _Pragma("unroll") for (int _i = 0; _i < 7; ++_i) { const int _t = _t0 + l0 - 3 + _i; raw[_i] = (_t >= 48) ? *(const u32x4*)(_src + (size_t)_t * 2048) : (u32x4){0u, 0u, 0u, 0u}; } \
        if (wave >= 4) { const int _t = _t0 + lane; const bool _v = _t >= 48; glf = _v ? GF[_t * 4 + (h)] : 0.f; gli = _v ? GI[_t * 4 + (h)] : NINF; } } while (0)
#define X_LOAD_G(c, h) do { const int _t0 = (c) * 64; const int _col = (h) * 128 + gd; \
        if (tid < 256) gav = ((const f32x4*)(GA + (size_t)_t0 * 16))[tid]; \
        _Pragma("unroll") for (int _i = 0; _i < 16; ++_i) { const int _t = _t0 + grp * 16 + _i; rq[_i] = (_t >= 48) ? RAW[(size_t)_t * 2048 + 1024 + _col] : (bf16_t)0; rk[_i] = (_t >= 48) ? RAW[(size_t)_t * 2048 + 1536 + _col] : (bf16_t)0; } } while (0)

    int item = item0;
    if (item < NIT) { X_DECODE(item, c, br, h); if (br == 0) X_LOAD_M(c, h); else X_LOAD_G(c, h); }
    bool need = false;
    for (; item < NIT; item += (SINGLE ? NIT : GS)) {
        X_DECODE(item, c, br, h); const int t0 = c * 64, ix = c * 8 + br * 4 + h;
        if (need) { if (br == 0) X_LOAD_M(c, h); else X_LOAD_G(c, h); }
        need = false;
        if (!SINGLE) { const int nx = item + GS; if (nx < NIT) { X_DECODE(nx, c2, br2, h2); if (br2 != br) { if (br2 == 0) X_LOAD_M(c2, h2); else X_LOAD_G(c2, h2); } else need = true; } }
        if (br == 0) {
            const int ch0 = which * 512 + h * 128 + d8;
            const float* cw = p.in[4] + ch0; const float* cb = p.in[5] + ch0;
            f32x4 wv4[4][2];
#pragma unroll
            for (int j = 0; j < 4; ++j) { wv4[j][0] = *(const f32x4*)(cw + j * 1024); wv4[j][1] = *(const f32x4*)(cw + j * 1024 + 4); }
            const f32x4 bv0 = *(const f32x4*)cb, bv1 = *(const f32x4*)(cb + 4);
            if (wave >= 4) {
                const float lf = glf, li = gli;
                const float b = wave_scan_sum(lf);
                const float gtot = __int_as_float(__builtin_amdgcn_readlane(__float_as_int(b), 63));
                const float wl = gtot - b + li;
                const float Ml = wave_max(wl);
                const float e = __expf(wl - Ml);
                const float lib = li - b;
                const float pm = wave_scan_max(lib);
                const bool dead = (pm == NINF);
                sF[128 + 64 * (wave - 4) + lane] = e;
                if (wave == 4) {
                    sF[lane] = lib; sF[64 + lane] = dead ? 0.f : pm;
                    CHB[(c * 4 + h) * 64 + lane] = b; CHM[(c * 4 + h) * 64 + lane] = dead ? 0.f : (b + pm);
                    if (lane == 0) { CHG[(c * 4 + h) * 2] = gtot; CHG[(c * 4 + h) * 2 + 1] = Ml; } }
                asm volatile("s_waitcnt lgkmcnt(0)" ::: "memory");
            }
            {
                float res[4][8];
#pragma unroll
                for (int e2 = 0; e2 < 4; ++e2) {
#pragma unroll
                    for (int o = 0; o < 4; ++o) { float y0 = e2 < 2 ? bv0[2 * e2] : bv1[2 * e2 - 4], y1 = e2 < 2 ? bv0[2 * e2 + 1] : bv1[2 * e2 - 3];
#pragma unroll
                        for (int j = 0; j < 4; ++j) { const unsigned wv = raw[o + j][e2]; y0 += (e2 < 2 ? wv4[j][0][2 * e2] : wv4[j][1][2 * e2 - 4]) * bf_lo(wv); y1 += (e2 < 2 ? wv4[j][0][2 * e2 + 1] : wv4[j][1][2 * e2 - 3]) * bf_hi(wv); }
                        res[o][2 * e2] = siluf_(y0); res[o][2 * e2 + 1] = siluf_(y1); } }
                if (which == 0) {
#pragma unroll
                    for (int o = 0; o < 4; ++o) { u32x4 w; w.x = cvt_pk_bf16(res[o][0] * QSCALE, res[o][1] * QSCALE); w.y = cvt_pk_bf16(res[o][2] * QSCALE, res[o][3] * QSCALE);
                        w.z = cvt_pk_bf16(res[o][4] * QSCALE, res[o][5] * QSCALE); w.w = cvt_pk_bf16(res[o][6] * QSCALE, res[o][7] * QSCALE);
                        *(LAS u32x4*)(sAq + (l0 + o) * 136 + d8) = w; *(u32x4*)(AQ + (size_t)(t0 + l0 + o) * 1024 + h * 128 + d8) = w; }
                } else {
                    float ev[4];
#pragma unroll
                    for (int o = 0; o < 4; ++o) { ev[o] = sF[128 + 64 * (wave - 4) + l0 + o];
                        u32x4 w; w.x = cvt_pk_bf16(res[o][0], res[o][1]); w.y = cvt_pk_bf16(res[o][2], res[o][3]); w.z = cvt_pk_bf16(res[o][4], res[o][5]); w.w = cvt_pk_bf16(res[o][6], res[o][7]);
                        *(LAS u32x4*)(sBk + (l0 + o) * 136 + d8) = w; }
#pragma unroll
                    for (int e = 0; e < 8; ++e) { u32x2 w; w.x = cvt_pk_bf16(res[0][e] * ev[0], res[1][e] * ev[1]); w.y = cvt_pk_bf16(res[2][e] * ev[2], res[3][e] * ev[3]);
                        *(LAS u32x2*)(sKt + (d8 + e) * 72 + l0) = w; }
                }
            }
        } else {
            const int d = gd, col = h * 128 + d;
            float a2[16];
#pragma unroll
            for (int r = 0; r < 16; ++r) a2[r] = p.in[7][r * 512 + col];
            const float bias = p.in[8][col];
            if (tid < 256) ((LAS f32x4*)sga)[tid] = gav;
            LDS_BARRIER();
            float cs[16]; float run = 0.f;
#pragma unroll
            for (int i = 0; i < 16; ++i) { const int l = grp * 16 + i; float za = bias;
#pragma unroll
                for (int q = 0; q < 4; ++q) { const f32x4 gv = *(const LAS f32x4*)(sga + l * 16 + 4 * q); za += (gv[0] * a2[4 * q] + gv[1] * a2[4 * q + 1]) + (gv[2] * a2[4 * q + 2] + gv[3] * a2[4 * q + 3]); }
                const float la = (t0 + l >= 48) ? logsigmoidf_(za) * (1.f / 16.f) : 0.f;
                run += la; cs[i] = run; }
            part[grp * 128 + d] = run;
            LDS_BARRIER();
            float off = 0.f, btot = 0.f;
#pragma unroll
            for (int g2 = 0; g2 < 4; ++g2) { const float pv = part[g2 * 128 + d]; btot += pv; if (g2 < grp) off += pv; }
            if (grp == 0) BT[(c * 4 + h) * 128 + d] = btot;
            float kend[16];
#pragma unroll
            for (int i = 0; i < 16; ++i) { const int l = grp * 16 + i, t = t0 + l; const float bc = cs[i] + off;
                const float gq = bf2f(rq[i]), gk = bf2f(rk[i]);
                const bf16_t qd = f2bf(gq * QSCALE * __expf(bc));
                sAq[l * 136 + d] = qd; AQ[(size_t)t * 1024 + 512 + col] = qd;
                sBk[l * 136 + d] = f2bf(gk * __expf(-bc));
                kend[i] = gk * __expf(btot - bc); }
            u32x4 w0, w1;
            w0.x = cvt_pk_bf16(kend[0], kend[1]); w0.y = cvt_pk_bf16(kend[2], kend[3]); w0.z = cvt_pk_bf16(kend[4], kend[5]); w0.w = cvt_pk_bf16(kend[6], kend[7]);
            w1.x = cvt_pk_bf16(kend[8], kend[9]); w1.y = cvt_pk_bf16(kend[10], kend[11]); w1.z = cvt_pk_bf16(kend[12], kend[13]); w1.w = cvt_pk_bf16(kend[14], kend[15]);
            *(LAS u32x4*)(sKt + d * 72 + grp * 16) = w0; *(LAS u32x4*)(sKt + d * 72 + grp * 16 + 8) = w1;
        }
        LDS_BARRIER();
        {
            const int jt = wave & 3, sh = wave >> 2, j = jt * 16 + fr;
            const float pmj = br == 0 ? sF[64 + j] : 0.f;
#pragma unroll
            for (int q = 0; q < 2; ++q) { const int st = 2 * sh + q;
                f32x4 acc = (f32x4){0.f, 0.f, 0.f, 0.f};
                if (st <= jt) {
#pragma unroll
                    for (int ks = 0; ks < 4; ++ks) { const bf16x8 kf = *(const LAS bf16x8*)(sBk + (st * 16 + fr) * 136 + ks * 32 + fq * 8), qf = *(const LAS bf16x8*)(sAq + j * 136 + ks * 32 + fq * 8);
                        acc = MFMA16(kf, qf, acc); }
#pragma unroll
                    for (int i = 0; i < 4; ++i) { const int s2 = st * 16 + fq * 4 + i; float dd = 0.f; if (s2 <= j) dd = br == 0 ? __expf(sF[s2] - pmj) : 1.f; acc[i] = (s2 <= j) ? acc[i] * dd : 0.f; }
                }
                u32x2 w; w.x = cvt_pk_bf16(acc[0], acc[1]); w.y = cvt_pk_bf16(acc[2], acc[3]);
                *(u32x2*)(WW + (size_t)ix * 4096 + j * 64 + st * 16 + fq * 4) = w; }
        }
#pragma unroll
        for (int i = 0; i < 2; ++i) { const int pc = tid + 512 * i, row = pc >> 3, sg = pc & 7;
            *(u32x4*)(KU + (size_t)ix * 8192 + pc * 8) = *(const LAS u32x4*)(sKt + row * 72 + sg * 8); }
        LDS_BARRIER();
    }
#undef X_DECODE
#undef X_LOAD_M
#undef X_LOAD_G
}

constexpr int SL_AQ = 0, SL_W = 17408, SL_KT = 26624, SL_VT = 45056, SL_CB = 56576, SL_CH = 78336, SL_ROW = 80896;
template <bool ML, bool PASSC>
__device__ __forceinline__ void scan_item(const Params& p, LAS unsigned char* L, const int qid, const int h, const int sl, const int g) {
    constexpr int NVT = ML ? 5 : 4, NT = ML ? 3 : 2;
    constexpr int NG = 1, TG = 512 / NG;
    constexpr int NLQ = 1024 / TG, NLW = 512 / TG, NLK = 1024 / TG, NLV = 512 / TG;
    const int tid = threadIdx.x, lane = tid & 63, wave = __builtin_amdgcn_readfirstlane(tid >> 6), fr = lane & 15, fq = lane >> 4;
    const int br = ML ? 0 : 1; const int item = qid * 4 + sl;
    const int gi = wave / (8 / NG), gt = tid & (TG - 1);
    unsigned char* ws = p.ws;
    const bf16_t* AQ = (const bf16_t*)(ws + WS_AQ); const bf16_t* KU = (const bf16_t*)(ws + WS_KU); const bf16_t* WW = (const bf16_t*)((const unsigned char*)p.out + OUT_WW);
    const bf16_t* V = (const bf16_t*)(ws + WS_R2); bf16_t* H = (bf16_t*)(ws + WS_R1); float* HSS = (float*)(ws + WS_HSS);
    const float* CHB = (const float*)(ws + WS_CHB); const float* CHM = (const float*)(ws + WS_CHM); const float* CHG = (const float*)(ws + WS_CHG); const float* BT = (const float*)(ws + WS_BT);
    f32x4* SEG = (f32x4*)(ws + WS_SEG);
    LAS bf16_t* sAq = (LAS bf16_t*)(L + SL_AQ); LAS bf16_t* sW = (LAS bf16_t*)(L + SL_W); LAS bf16_t* sKt = (LAS bf16_t*)(L + SL_KT);
    LAS bf16_t* sVt = (LAS bf16_t*)(L + SL_VT); LAS bf16_t* sCb = (LAS bf16_t*)(L + SL_CB); LAS float* sCH = (LAS float*)(L + SL_CH); LAS float* sRow = (LAS float*)(L + SL_ROW);
    const int cs = seg_start_b(ML, g), ce = seg_start_b(ML, g + 1);
    const int dt = wave, jt = wave & 3, vh = wave >> 2;

    u32x4 rq[NLQ], rw[NLW], rk[NLK], rv[NLV]; float rs = 0.f;
#define SCAN_LOAD(c) do { const int _t0 = (c) * 64; const int _ix = (c) * 8 + br * 4 + h; \
        if (PASSC) { _Pragma("unroll") for (int _i = 0; _i < NLQ; ++_i) { const int _p = gt + TG * _i; rq[_i] = *(const u32x4*)(AQ + (size_t)(_t0 + (_p >> 4)) * 1024 + br * 512 + h * 128 + (_p & 15) * 8); } \
            _Pragma("unroll") for (int _i = 0; _i < NLW; ++_i) rw[_i] = *(const u32x4*)(WW + (size_t)_ix * 4096 + (gt + TG * _i) * 8); } \
        _Pragma("unroll") for (int _i = 0; _i < NLK; ++_i) rk[_i] = *(const u32x4*)(KU + (size_t)_ix * 8192 + (gt + TG * _i) * 8); \
        _Pragma("unroll") for (int _i = 0; _i < NLV; ++_i) { const int _p = gt + TG * _i, _l = _p & 63, _pc = _p >> 6; \
            rv[_i] = (_t0 + _l >= 48) ? *(const u32x4*)(V + (size_t)(_t0 + _l) * 2048 + br * 1024 + h * 256 + sl * 64 + _pc * 8) : (u32x4){0u, 0u, 0u, 0u}; } \
        if (gt < 128) { if (ML) { if (PASSC) rs = (gt < 64) ? CHB[((c) * 4 + h) * 64 + gt] : CHM[((c) * 4 + h) * 64 + gt - 64]; } \
        else rs = BT[(size_t)((c) * 4 + h) * 128 + gt]; } } while (0)
#define SCAN_WRITE() do { \
        if (PASSC) { _Pragma("unroll") for (int _i = 0; _i < NLQ; ++_i) { const int _p = gt + TG * _i; *(LAS u32x4*)(sAq + (_p >> 4) * 136 + (_p & 15) * 8) = rq[_i]; } \
            _Pragma("unroll") for (int _i = 0; _i < NLW; ++_i) { const int _p = gt + TG * _i; *(LAS u32x4*)(sW + (_p >> 3) * 72 + (_p & 7) * 8) = rw[_i]; } } \
        _Pragma("unroll") for (int _i = 0; _i < NLK; ++_i) { const int _p = gt + TG * _i; *(LAS u32x4*)(sKt + (_p >> 3) * 72 + (_p & 7) * 8) = rk[_i]; } \
        _Pragma("unroll") for (int _i = 0; _i < NLV; ++_i) { const int _p = gt + TG * _i, _l = _p & 63, _pc = _p >> 6; \
            _Pragma("unroll") for (int _e = 0; _e < 4; ++_e) { const unsigned _wv = rv[_i][_e]; sVt[(_pc * 8 + 2 * _e) * 72 + _l] = (bf16_t)(_wv & 0xffffu); sVt[(_pc * 8 + 2 * _e + 1) * 72 + _l] = (bf16_t)(_wv >> 16); } } \
        if ((!ML || PASSC) && gt < 128) sRow[gt] = rs; } while (0)
#pragma unroll
    for (int k = 0; k < NG; ++k) { if (gi == k && cs + k < ce) SCAN_LOAD(cs + k); }

    if (ML) { if (tid < 128) { const int row = 64 + (tid >> 3), sg = tid & 7; const unsigned one = (row == 64) ? 0x3F803F80u : 0u; *(LAS u32x4*)(sVt + row * 72 + sg * 8) = (u32x4){one, one, one, one}; }
        for (int i = tid; i < NCH * 2; i += 512) sCH[i] = CHG[(i >> 1) * 8 + h * 2 + (i & 1)]; }
    LDS_BARRIER();

    f32x4 st[NVT];
#pragma unroll
    for (int vt = 0; vt < NVT; ++vt) st[vt] = (f32x4){0.f, 0.f, 0.f, 0.f};
    float mrun = 0.f; f32x4 btacc = (f32x4){0.f, 0.f, 0.f, 0.f};
    for (int gp = 0; gp < g; ++gp) {
        const int c0 = seg_start_b(ML, gp), c1 = seg_start_b(ML, gp + 1);
        f32x4 F;
        if (ML) { float Fl = 0.f;
#pragma unroll 8
            for (int c = c0; c < c1; ++c) { const float gc = sCH[2 * c], Ml = sCH[2 * c + 1]; const float mn = fmaxf(gc + mrun, Ml); Fl += gc + mrun - mn; mrun = mn; }
            const float f = __expf(Fl); F = (f32x4){f, f, f, f}; }
        else { f32x4 s4 = (f32x4){0.f, 0.f, 0.f, 0.f}; if (PASSC) s4 = *(const f32x4*)((const float*)(ws + WS_SEGBT) + (size_t)(h * 8 + gp) * 128 + dt * 16 + fq * 4);
            F = (f32x4){__expf(s4[0]), __expf(s4[1]), __expf(s4[2]), __expf(s4[3])}; }
        if (PASSC) { const int it2 = (qid - g + gp) * 4 + sl;
#pragma unroll
            for (int vt = 0; vt < NVT; ++vt) { const f32x4 Lv = SEG[((size_t)(it2 * 8 + dt) * 5 + vt) * 64 + lane]; st[vt] = F * st[vt] + Lv; } }
    }
    if (PASSC) {
#pragma unroll
        for (int vt = 0; vt < NVT; ++vt) { u32x2 w; w.x = cvt_pk_bf16(st[vt][0], st[vt][1]); w.y = cvt_pk_bf16(st[vt][2], st[vt][3]); *(LAS u32x2*)(sCb + (vt * 16 + fr) * 136 + dt * 16 + fq * 4) = w; }
    }

    for (int c = cs; c < ce; ++c) {
        if (gi == ((c - cs) & (NG - 1))) { SCAN_WRITE(); if (c + NG < ce) SCAN_LOAD(c + NG); }
        LDS_BARRIER();
        float a_c = 1.f, u_c = 1.f, a_int = 1.f, r_int = 1.f, clampv = 1.f; f32x4 dec = (f32x4){1.f, 1.f, 1.f, 1.f};
        if (ML) { const float gc = sCH[2 * c], Ml = sCH[2 * c + 1]; const float mn = fmaxf(gc + mrun, Ml); a_c = __expf(gc + mrun - mn); u_c = __expf(Ml - mn);
            if (PASSC && c > 0) { const float bj = sRow[jt * 16 + fr], mr = sRow[64 + jt * 16 + fr]; const float mrow = fmaxf(bj + mrun, mr);
                a_int = __expf(bj + mrun - mrow); r_int = __expf(mr - mrow); clampv = __expf(-mrow); }
            mrun = mn; }
        else { const f32x4 b4 = *(const LAS f32x4*)(sRow + dt * 16 + fq * 4); dec = (f32x4){__expf(b4[0]), __expf(b4[1]), __expf(b4[2]), __expf(b4[3])}; btacc += b4; }
        if (PASSC && c > 0) {
            f32x4 ai[NT], ae[NT];
#pragma unroll
            for (int q = 0; q < NT; ++q) { ai[q] = (f32x4){0.f, 0.f, 0.f, 0.f}; ae[q] = (f32x4){0.f, 0.f, 0.f, 0.f}; }
#pragma unroll
            for (int ks = 0; ks < 2; ++ks) { const bf16x8 wf = *(const LAS bf16x8*)(sW + (jt * 16 + fr) * 72 + ks * 32 + fq * 8);
#pragma unroll
                for (int q = 0; q < NT; ++q) { const int vt = q < 2 ? 2 * vh + q : 4; const bf16x8 vf = *(const LAS bf16x8*)(sVt + (vt * 16 + fr) * 72 + ks * 32 + fq * 8); ai[q] = MFMA16(vf, wf, ai[q]); } }
#pragma unroll
            for (int ks = 0; ks < 4; ++ks) { const bf16x8 af = *(const LAS bf16x8*)(sAq + (jt * 16 + fr) * 136 + ks * 32 + fq * 8);
#pragma unroll
                for (int q = 0; q < NT; ++q) { const int vt = q < 2 ? 2 * vh + q : 4; const bf16x8 cf = *(const LAS bf16x8*)(sCb + (vt * 16 + fr) * 136 + ks * 32 + fq * 8); ae[q] = MFMA16(cf, af, ae[q]); } }
            float dn = 1.f;
            if (ML) { const float denv = a_int * ae[NT - 1][0] + r_int * ai[NT - 1][0]; const float den = __shfl(denv, fr); dn = __builtin_amdgcn_rcpf(fmaxf(fabsf(den), clampv)); }
            const int row = (c - 1) * 64 + jt * 16 + fr; float ss = 0.f;
#pragma unroll
            for (int q = 0; q < 2; ++q) { f32x4 hv;
#pragma unroll
                for (int i = 0; i < 4; ++i) { hv[i] = ML ? (a_int * ae[q][i] + r_int * ai[q][i]) * dn : (ae[q][i] + ai[q][i]); ss += hv[i] * hv[i]; }
                u32x2 w; w.x = cvt_pk_bf16(hv[0], hv[1]); w.y = cvt_pk_bf16(hv[2], hv[3]);
                *(u32x2*)(H + (size_t)row * 2048 + br * 1024 + h * 256 + sl * 64 + (2 * vh + q) * 16 + fq * 4) = w; }
            ss += __shfl_xor(ss, 16); ss += __shfl_xor(ss, 32);
            if (fq == 0) HSS[(size_t)row * 64 + br * 32 + h * 8 + sl * 2 + vh] = ss;
        }
        f32x4 dl[NVT];
#pragma unroll
        for (int vt = 0; vt < NVT; ++vt) dl[vt] = (f32x4){0.f, 0.f, 0.f, 0.f};
#pragma unroll
        for (int ks = 0; ks < 2; ++ks) { const bf16x8 kf = *(const LAS bf16x8*)(sKt + (dt * 16 + fr) * 72 + ks * 32 + fq * 8);
#pragma unroll
            for (int vt = 0; vt < NVT; ++vt) { const bf16x8 vf = *(const LAS bf16x8*)(sVt + (vt * 16 + fr) * 72 + ks * 32 + fq * 8); dl[vt] = MFMA16(kf, vf, dl[vt]); } }
        LDS_BARRIER();
#pragma unroll
        for (int vt = 0; vt < NVT; ++vt) { if (ML) st[vt] = st[vt] * a_c + dl[vt] * u_c; else st[vt] = st[vt] * dec + dl[vt];
            if (PASSC) { u32x2 w; w.x = cvt_pk_bf16(st[vt][0], st[vt][1]); w.y = cvt_pk_bf16(st[vt][2], st[vt][3]); *(LAS u32x2*)(sCb + (vt * 16 + fr) * 136 + dt * 16 + fq * 4) = w; } }
    }
#undef SCAN_LOAD
#undef SCAN_WRITE
    if (!PASSC) {
#pragma unroll
        for (int vt = 0; vt < NVT; ++vt) SEG[((size_t)(item * 8 + dt) * 5 + vt) * 64 + lane] = st[vt];
        if (!ML && sl == 0 && fr == 0) *(f32x4*)((float*)(ws + WS_SEGBT) + (size_t)(h * 8 + g) * 128 + dt * 16 + fq * 4) = btacc;
    }
    LDS_BARRIER();
}

__device__ __forceinline__ void scan_phase(const Params& p, LAS unsigned char* L, const bool passC) {
    for (int b = blockIdx.x; b < 256; b += gridDim.x) {
        const int x = b & 7, y = b >> 3, qid = x + 8 * (y >> 2), sl = y & 3;
        const bool ml = qid < 4 * NSEG_M;
        const int qq = ml ? qid : qid - 4 * NSEG_M, ns = ml ? NSEG_M : NSEG_G, h = qq / ns, g = qq - h * ns;
        if (!passC && g == ns - 1) continue;
        if (passC) { if (ml) scan_item<true, true>(p, L, qid, h, sl, g); else scan_item<false, true>(p, L, qid, h, sl, g); }
        else { if (ml) scan_item<true, false>(p, L, qid, h, sl, g); else scan_item<false, false>(p, L, qid, h, sl, g); }
    }
}

__global__ void __launch_bounds__(512, 2) fwd_megakernel(Params p) {
    extern __shared__ __attribute__((aligned(16))) unsigned char lds_raw[];
    LAS unsigned char* L = (LAS unsigned char*)lds_raw;
    cg::grid_group grid = cg::this_grid();
    const int lo = p.ph_lo, hi = p.ph_hi, G = gridDim.x;
    unsigned char* ws = p.ws;
#define IN(k) (lo <= (k) && (k) < hi)
#define SEAM(k) do { if (IN(k) && IN((k) + 1)) xcd_barrier(bar); } while (0)
    if (lo < 0) grid.sync();
    if (threadIdx.x < 16) ((LAS unsigned*)(L + MISC_OFF))[threadIdx.x] = 0u;
    __syncthreads();
    XcdBarrier bar = xcd_barrier_post((unsigned*)(ws + WS_BAR), (volatile LAS unsigned*)(L + MISC_OFF));
    if (IN(0)) p0_prologue(p, L);
    SEAM(0);
    if (IN(1)) { pg8::Gemm g{(const bf16_t*)((const unsigned char*)p.out + OUT_XN), (const bf16_t*)(ws + WS_WTA), SEQ, 4096, 1024, 1024, 0, 0};
        pg8::StaticOrder S; S.init(SEQ, 4096, G, (int)blockIdx.x);
        pg8::EpiQKV E{(bf16_t*)(ws + WS_R1), (bf16_t*)(ws + WS_R2)};
        pg8::gemm_phase<pg8::EpiQKV, pg8::StaticOrder>(L, g, S, E); }
    SEAM(1);
    if (IN(2)) x_phase<false>(p, L, (int)blockIdx.x, (G == 256 ? (NCH - 1) * 8 : NCH * 8), G);
    SEAM(2);
    if (IN(3)) {
        if (G == 256) { const int b = blockIdx.x, x = b & 7, y = b >> 3, qid = x + 8 * (y >> 2), sl = y & 3; const bool ml = qid < 4 * NSEG_M;
            const int qq = ml ? qid : qid - 4 * NSEG_M, ns = ml ? NSEG_M : NSEG_G, hh = qq / ns, gg = qq - hh * ns;
            if (gg == ns - 1 && sl == 0) { const int it = (NCH - 1) * 8 + (ml ? 0 : 4) + hh; x_phase<true>(p, L, it, it + 1, 256); } }
        scan_phase(p, L, false);
    }
    SEAM(3);
    if (IN(4)) scan_phase(p, L, true);
    SEAM(4);
    if (IN(5)) { pg8::Gemm g{(const bf16_t*)((const unsigned char*)p.out + OUT_XN), (const bf16_t*)(ws + WS_WTB), SEQ, 4096, 1024, 1024, 0, 0};
        pg8::StaticOrder S; S.init(SEQ, 4096, G, (int)blockIdx.x);
        pg8::EpiGate E{(bf16_t*)(ws + WS_R1), (bf16_t*)(ws + WS_R2), (const float*)(ws + WS_HSS), p.in[9], p.in[10]};
        pg8::gemm_phase<pg8::EpiGate, pg8::StaticOrder>(L, g, S, E); }
    SEAM(5);
    if (IN(6)) { pg8::Gemm g{(const bf16_t*)(ws + WS_R1), (const bf16_t*)(ws + WS_WTBM), SEQ, 1024, 1024, 2048, (size_t)1024 * 2, (size_t)2 * MiB};
        pg8::TwoPassOrder S; S.init(SEQ, 1024, G, (int)blockIdx.x);
        pg8::EpiMerge E{(bf16_t*)(ws + WS_AQ), (const bf16_t*)(ws + WS_R2)};
        pg8::gemm_phase<pg8::EpiMerge, pg8::TwoPassOrder>(L, g, S, E); }
    SEAM(6);
    if (IN(7)) { pg8::Gemm g{(const bf16_t*)(ws + WS_AQ), (const bf16_t*)(ws + WS_WTO), SEQ, 1024, 1024, 1024, 0, 0};
        pg8::StaticOrder S; S.init(SEQ, 1024, G, (int)blockIdx.x);
        pg8::EpiResid E{p.in[0], (bf16_t*)(ws + WS_KU), (float*)(ws + WS_SS1)};
        pg8::gemm_phase<pg8::EpiResid, pg8::StaticOrder>(L, g, S, E); }
    SEAM(7);
    if (IN(8)) { pg8::Gemm g{(const bf16_t*)(ws + WS_KU), (const bf16_t*)(ws + WS_WTFF), SEQ, 2 * DFF, 1024, 1024, 0, 0};
        pg8::StaticOrder S; S.init(SEQ, 2 * DFF, G, (int)blockIdx.x);
        pg8::EpiFF E{(bf16_t*)(ws + WS_FF), (const float*)(ws + WS_SS1)};
        pg8::gemm_phase<pg8::EpiFF, pg8::StaticOrder>(L, g, S, E); }
    SEAM(8);
    if (IN(9)) { pg8::Gemm g{(const bf16_t*)(ws + WS_FF), (const bf16_t*)(ws + WS_WTD), SEQ, 1024, DFF, DFF, 0, 0};
        pg8::StaticOrder S; S.init(SEQ, 1024, G, (int)blockIdx.x);
        pg8::EpiFinal E{p.out, (const bf16_t*)(ws + WS_KU), p.in[18], (float*)(ws + WS_SS2), (unsigned*)(ws + WS_PCNT)};
        pg8::gemm_phase<pg8::EpiFinal, pg8::StaticOrder>(L, g, S, E); }
#undef IN
#undef SEAM
}

extern "C" void kernel_launch(void* const* d_in, const int* in_sizes, int n_in, void* d_out, int out_size, void* d_ws, size_t ws_size, hipStream_t stream) {
    static int grid = 0;
    if (grid == 0) {
        if (n_in != 19 || out_size != SEQ * DM || ws_size < WS_END) { fprintf(stderr, "kernel_launch: unexpected sizes (n_in %d out %d ws %zu)\n", n_in, out_size, ws_size); grid = -1; return; }
        int dev = 0, cus = 0, per_cu = 0;
        (void)hipGetDevice(&dev); (void)hipDeviceGetAttribute(&cus, hipDeviceAttributeMultiprocessorCount, dev);
        if (hipFuncSetAttribute((const void*)fwd_megakernel, hipFuncAttributeMaxDynamicSharedMemorySize, LDS_BYTES) != hipSuccess) { fprintf(stderr, "kernel_launch: hipFuncSetAttribute failed\n"); grid = -1; return; }
        if (hipOccupancyMaxActiveBlocksPerMultiprocessor(&per_cu, (const void*)fwd_megakernel, 512, LDS_BYTES) != hipSuccess || per_cu < 1) { fprintf(stderr, "kernel_launch: occupancy query says %d\n", per_cu); per_cu = 1; }
        (void)hipGetLastError();
        grid = cus * 1;
        if (grid <= 0) grid = 256;
    }
    if (grid < 0) return;
    if (hipMemsetAsync(d_ws, 0, CTL_ZERO_BYTES, stream) != hipSuccess) { fprintf(stderr, "kernel_launch: memset failed\n"); return; }
    Params a{};
    for (int i = 0; i < 19; ++i) a.in[i] = (const float*)d_in[i];
    a.out = (float*)d_out; a.ws = (unsigned char*)d_ws;
#if N_LAUNCH_MODE == 1
    a.ph_lo = 0; a.ph_hi = 10;
    void* args[] = {&a};
    hipError_t e = hipLaunchCooperativeKernel((const void*)fwd_megakernel, dim3(grid), dim3(512), args, LDS_BYTES, stream);
    if (e != hipSuccess) fprintf(stderr, "cooperative launch failed: %s (grid %d)\n", hipGetErrorString(e), grid);
#else
    for (int ph = 0; ph < 10; ++ph) { a.ph_lo = ph; a.ph_hi = ph + 1;
        hipLaunchKernelGGL(fwd_megakernel, dim3(grid), dim3(512), LDS_BYTES, stream, a); }
#endif
}
```
